# Optimizing an MI355X kernel written in HIP

```python
import math
import jax, jax.numpy as jnp
from jax import lax
import numpy as np

D_MODEL = 1024
BATCH = 4
SEQ = 4096
DEPTH = 2
DEC_BATCH = 32
DEC_SEQ = 8
PAST_LEN = 16384
PAGE_SIZE = 128

A_HEADS = 8
A_HEAD_DIM = 64
A_WIDTH = A_HEADS * A_HEAD_DIM
DILATED_PATTERNS = ((128, 1), (512, 4), (2048, 16))
WIN_MAX = max(w for w, _ in DILATED_PATTERNS)
B_HEADS = 4
B_KEY_DIM = 128
B_VAL_DIM = 128
B_KEY_WIDTH = B_HEADS * B_KEY_DIM
B_VAL_WIDTH = B_HEADS * B_VAL_DIM
HGRN_CHUNK = 64
D_FF = 2816
NORM_EPS = 1e-6
IN_SPLIT_SIZES = (A_WIDTH, A_WIDTH, A_WIDTH, B_KEY_WIDTH, B_KEY_WIDTH, B_VAL_WIDTH, B_VAL_WIDTH)
IN_WIDTH = sum(IN_SPLIT_SIZES)
MIX_WIDTH = A_WIDTH + B_VAL_WIDTH

kernel_name = 'hybrid_dilated_attn_hgrn2_macaron_step'


def rmsnorm(x, g):
    xf = x.astype(jnp.float32)
    y = xf * lax.rsqrt(jnp.mean(xf * xf, axis=-1, keepdims=True) + NORM_EPS)
    return (y * g.astype(jnp.float32)).astype(x.dtype)


def swiglu(x, w_gate, w_up, w_down):
    return (jax.nn.silu(x @ w_gate) * (x @ w_up)) @ w_down


def dilated_window_prompt(q, k, v, window, dilation):
    B, S, H, Dh = q.shape
    steps = window // dilation
    n = S // dilation
    nb = -(-n // steps)
    pad = nb * steps - n

    def to_blocks(t):
        t = t.reshape(B, n, dilation, H, Dh).transpose(0, 2, 1, 3, 4)
        t = jnp.pad(t, ((0, 0), (0, 0), (0, pad), (0, 0), (0, 0)))
        return t.reshape(B, dilation, nb, steps, H, Dh)

    def with_prev(t):
        prev = jnp.pad(t, ((0, 0), (0, 0), (1, 0), (0, 0), (0, 0), (0, 0)))[:, :, :-1]
        return jnp.concatenate([prev, t], axis=3)

    qb = to_blocks(q)
    kw = with_prev(to_blocks(k))
    vw = with_prev(to_blocks(v))
    s = jnp.einsum('brcqhd,brckhd->brchqk', qb, kw).astype(jnp.float32) / math.sqrt(Dh)
    qi = jnp.arange(steps)[:, None]
    ki = jnp.arange(2 * steps)[None, :]
    dist = steps + qi - ki
    band = (dist >= 0) & (dist <= steps)
    exists = (jnp.arange(nb) > 0)[:, None, None] | (ki >= steps)[None]
    mask = band[None] & exists
    s = jnp.where(mask[:, None], s, -jnp.inf)
    lse = jax.nn.logsumexp(s, axis=-1)
    p = jnp.exp(s - lse[..., None])
    o = jnp.einsum('brchqk,brckhd->brcqhd', p, vw.astype(jnp.float32))
    o = o.reshape(B, dilation, nb * steps, H, Dh)[:, :, :n]
    o = o.transpose(0, 2, 1, 3, 4).reshape(B, S, H, Dh)
    lse = lse.transpose(0, 1, 2, 4, 3).reshape(B, dilation, nb * steps, H)[:, :, :n]
    lse = lse.transpose(0, 2, 1, 3).reshape(B, S, H)
    return o, lse


def dilated_window_sample(q, k_all, v_all, window, dilation):
    B, T, H, Dh = q.shape
    N = k_all.shape[1]
    steps = window // dilation
    idx = (N - T + jnp.arange(T))[:, None] - dilation * jnp.arange(steps + 1)[None, :]
    valid = idx >= 0
    idx = jnp.maximum(idx, 0)
    kg = k_all[:, idx]
    vg = v_all[:, idx]
    s = jnp.einsum('bthd,btjhd->bthj', q, kg).astype(jnp.float32) / math.sqrt(Dh)
    s = jnp.where(valid[:, None, :], s, -jnp.inf)
    lse = jax.nn.logsumexp(s, axis=-1)
    p = jnp.exp(s - lse[..., None])
    o = jnp.einsum('bthj,btjhd->bthd', p, vg.astype(jnp.float32))
    return o, lse


def dilated_mixture(outs):
    o = jnp.stack([oi for oi, _ in outs])
    lse = jnp.stack([li for _, li in outs])
    w = jax.nn.softmax(lse, axis=0)
    return jnp.sum(w[..., None] * o, axis=0)


def hgrn2_scan(q, k, v, log_f, s0, chunk):
    B, T, H, K = q.shape
    V = v.shape[-1]
    nc = T // chunk

    def split(t):
        return t.reshape(B, nc, chunk, H, t.shape[-1]).transpose(1, 0, 3, 2, 4)

    causal = jnp.tril(jnp.ones((chunk, chunk), dtype=bool))

    def step(S, xs):
        qc, kc, vc, gc = xs
        G = jnp.cumsum(gc, axis=2)
        o_inter = jnp.einsum('bhck,bhkv->bhcv', qc * jnp.exp(G), S)
        diff = G[:, :, :, None, :] - G[:, :, None, :, :]
        decay = jnp.exp(jnp.where(causal[:, :, None], diff, -jnp.inf))
        A = jnp.einsum('bhtk,bhsk,bhtsk->bhts', qc, kc, decay)
        o = o_inter + jnp.einsum('bhts,bhsv->bhtv', A, vc)
        G_last = G[:, :, -1:, :]
        S_new = jnp.exp(G_last[:, :, 0, :])[..., None] * S + jnp.einsum(
            'bhck,bhcv->bhkv', kc * jnp.exp(G_last - G), vc)
        return S_new, o

    S_fin, o = lax.scan(step, s0, (split(q), split(k), split(v), split(log_f)))
    o = o.transpose(1, 0, 3, 2, 4).reshape(B, T, H, V)
    return o, S_fin


def token_mixing(hn, w_in_l, attn_g_l, lb_l, hgrn_g_l, w_out_l, k_past, v_past, s0):
    B, T, _ = hn.shape
    f32 = jnp.float32
    z = hn @ w_in_l
    split_at = [int(c) for c in np.cumsum(IN_SPLIT_SIZES)[:-1]]
    aq, ak, av, bq, bf, bi, bg = jnp.split(z, split_at, axis=-1)
    aq = aq.reshape(B, T, A_HEADS, A_HEAD_DIM)
    ak = ak.reshape(B, T, A_HEADS, A_HEAD_DIM)
    av = av.reshape(B, T, A_HEADS, A_HEAD_DIM)

    if k_past is None:
        outs = [dilated_window_prompt(aq, ak, av, w, d) for (w, d) in DILATED_PATTERNS]
        keep = min(WIN_MAX, T)
        k_new, v_new = ak[:, T - keep:], av[:, T - keep:]
        s_init = jnp.zeros((B, B_HEADS, B_KEY_DIM, B_VAL_DIM), f32)
    else:
        k_all = jnp.concatenate([k_past.astype(ak.dtype), ak], axis=1)
        v_all = jnp.concatenate([v_past.astype(av.dtype), av], axis=1)
        outs = [dilated_window_sample(aq, k_all, v_all, w, d) for (w, d) in DILATED_PATTERNS]
        k_new, v_new = ak, av
        s_init = s0.astype(f32)
    o_a = rmsnorm(dilated_mixture(outs).reshape(B, T, A_WIDTH), attn_g_l)

    qh = jax.nn.silu(bq.astype(f32)).reshape(B, T, B_HEADS, B_KEY_DIM)
    f = lb_l + (1.0 - lb_l) * jax.nn.sigmoid(bf.astype(f32))
    f = f.reshape(B, T, B_HEADS, B_KEY_DIM)
    log_f = jnp.log(f)
    kh = 1.0 - f
    vh = bi.astype(f32).reshape(B, T, B_HEADS, B_VAL_DIM)
    chunk = HGRN_CHUNK if T % HGRN_CHUNK == 0 else T
    o_b, s_fin = hgrn2_scan(qh, kh, vh, log_f, s_init, chunk)
    o_b = rmsnorm(o_b, hgrn_g_l) * jax.nn.silu(bg.astype(f32).reshape(B, T, B_HEADS, B_VAL_DIM))

    o = jnp.concatenate([o_a, o_b.reshape(B, T, B_VAL_WIDTH)], axis=-1).astype(hn.dtype)
    return o @ w_out_l, k_new, v_new, s_fin


def setup_inputs(seed: int = 0) -> dict:
    key = jax.random.key(seed)
    ks = iter(jax.random.split(key, 32))
    f32 = jnp.float32
    win_buf = min(WIN_MAX, PAST_LEN)

    def w(shape, fan_in):
        return jax.random.normal(next(ks), shape, f32) * fan_in ** -0.5

    def gain(shape):
        return 1.0 + 0.02 * jax.random.normal(next(ks), shape, f32)

    return {
        'x_prompt': jax.random.normal(next(ks), (BATCH, SEQ, D_MODEL), f32),
        'x_sample': jax.random.normal(next(ks), (DEC_BATCH, DEC_SEQ, D_MODEL), f32),
        'cache_attn_k': jax.random.normal(next(ks), (DEPTH, DEC_BATCH, win_buf, A_HEADS, A_HEAD_DIM), f32),
        'cache_attn_v': jax.random.normal(next(ks), (DEPTH, DEC_BATCH, win_buf, A_HEADS, A_HEAD_DIM), f32),
        'state_hgrn': 0.3 * jax.random.normal(next(ks), (DEPTH, DEC_BATCH, B_HEADS, B_KEY_DIM, B_VAL_DIM), f32),
        'ff1_pre_g': gain((DEPTH, D_MODEL)),
        'ff1_w_gate': w((DEPTH, D_MODEL, D_FF), D_MODEL),
        'ff1_w_up': w((DEPTH, D_MODEL, D_FF), D_MODEL),
        'ff1_w_down': w((DEPTH, D_FF, D_MODEL), D_FF),
        'ff1_post_g': gain((DEPTH, D_MODEL)),
        'mix_pre_g': gain((DEPTH, D_MODEL)),
        'w_in': w((DEPTH, D_MODEL, IN_WIDTH), D_MODEL),
        'attn_norm_g': gain((DEPTH, A_WIDTH)),
        'hgrn_lb_logits': 0.5 * jax.random.normal(next(ks), (DEPTH, B_KEY_WIDTH), f32),
        'hgrn_norm_g': gain((DEPTH, B_VAL_DIM)),
        'w_out': w((DEPTH, MIX_WIDTH, D_MODEL), MIX_WIDTH),
        'mix_post_g': gain((DEPTH, D_MODEL)),
        'ff2_pre_g': gain((DEPTH, D_MODEL)),
        'ff2_w_gate': w((DEPTH, D_MODEL, D_FF), D_MODEL),
        'ff2_w_up': w((DEPTH, D_MODEL, D_FF), D_MODEL),
        'ff2_w_down': w((DEPTH, D_FF, D_MODEL), D_FF),
        'ff2_post_g': gain((DEPTH, D_MODEL)),
    }


def reference(x_prompt, x_sample, cache_attn_k, cache_attn_v, state_hgrn,
              ff1_pre_g, ff1_w_gate, ff1_w_up, ff1_w_down, ff1_post_g,
              mix_pre_g, w_in, attn_norm_g, hgrn_lb_logits, hgrn_norm_g, w_out, mix_post_g,
              ff2_pre_g, ff2_w_gate, ff2_w_up, ff2_w_down, ff2_post_g):
    lb_soft = jax.nn.softmax(hgrn_lb_logits.astype(jnp.float32), axis=0)
    lower_bounds = jnp.cumsum(lb_soft, axis=0) - lb_soft[0]

    def layer(x, l, k_past, v_past, s0):
        h = x + 0.5 * rmsnorm(swiglu(rmsnorm(x, ff1_pre_g[l]), ff1_w_gate[l], ff1_w_up[l], ff1_w_down[l]),
                              ff1_post_g[l])
        m, k_new, v_new, s_new = token_mixing(rmsnorm(h, mix_pre_g[l]), w_in[l], attn_norm_g[l],
                                              lower_bounds[l], hgrn_norm_g[l], w_out[l], k_past, v_past, s0)
        h = h + rmsnorm(m, mix_post_g[l])
        h = h + 0.5 * rmsnorm(swiglu(rmsnorm(h, ff2_pre_g[l]), ff2_w_gate[l], ff2_w_up[l], ff2_w_down[l]),
                              ff2_post_g[l])
        return h, k_new, v_new, s_new

    hp, hs = x_prompt, x_sample
    kp_l, vp_l, sp_l, ks_l, vs_l, ss_l = [], [], [], [], [], []
    for l in range(DEPTH):
        hp, kp, vp, sp = layer(hp, l, None, None, None)
        hs, kd, vd, sd = layer(hs, l, cache_attn_k[l], cache_attn_v[l], state_hgrn[l])
        kp_l.append(kp); vp_l.append(vp); sp_l.append(sp)
        ks_l.append(kd); vs_l.append(vd); ss_l.append(sd)
    new_k_prompt = jnp.stack(kp_l)
    new_v_prompt = jnp.stack(vp_l)
    new_state_prompt = jnp.stack(sp_l)
    new_k_sample = jnp.stack(ks_l)
    new_v_sample = jnp.stack(vs_l)
    new_state_sample = jnp.stack(ss_l)
    return (hp, hs, new_k_prompt, new_v_prompt, new_state_prompt, new_k_sample, new_v_sample, new_state_sample)
```

```cpp
#include <hip/hip_runtime.h>
#include <hip/hip_cooperative_groups.h>
#include <cstdio>
#include <cstdint>
namespace cg = cooperative_groups;

#ifndef MK_MULTI
#define MK_MULTI 0
#endif

namespace pg8 {
#define PG8_LAS __attribute__((address_space(3)))
typedef unsigned short bf16_t;
typedef short bf16x8 __attribute__((ext_vector_type(8)));
typedef float f32x4 __attribute__((ext_vector_type(4)));
typedef unsigned u32x4 __attribute__((ext_vector_type(4)));
constexpr int BM = 256, BK = 64, HALF = 128, HTB = HALF * BK * 2  , STAGE_BYTES = 8 * HTB, NXCD = 8, WGM = 8;

__host__ __device__ __forceinline__ int lds_byte(int r, int c) { const int st = (r >> 4) * 2 + (c >> 5), rr = r & 15, cc = c & 31, ob = rr * 64 + cc * 2; return st * 1024 + (ob ^ (((ob >> 9) & 1) << 5)); }
__host__ __device__ __forceinline__ void stage_rc(int b, int& R, int& C) { const int st = b / 1024, sb = b % 1024, swz = sb ^ (((sb >> 9) & 1) << 5); R = (st >> 1) * 16 + swz / 64; C = (st & 1) * 32 + (swz % 64) / 2; }
__host__ __device__ __forceinline__ int perm32(int rho) { const int n = rho >> 4, i = rho & 15; return 8 * (i >> 2) + 4 * n + (i & 3); }

struct Unit { int pm, pn; };
struct Gemm { const bf16_t* A; const bf16_t* Bt; int M, N, K; };

struct StaticOrder {
    int nM, nN, nwg, G, c;
    __host__ __device__ void init(int M, int N, int G_, int c_) { nM = M / BM; nN = N / BM; nwg = nM * nN; G = G_; c = c_; }
    __host__ __device__ bool next(int i, Unit& u) const {
        const long L = (long)i * G + c; if (L >= nwg) return false;
        int wgid = (int)L; { const int q = nwg / NXCD, r = nwg % NXCD, xcd = wgid % NXCD, off = wgid / NXCD; wgid = (xcd < r ? xcd * (q + 1) : r * (q + 1) + (xcd - r) * q) + off; }
        const int nig = WGM * nN, gid = wgid / nig, fm = gid * WGM, gsz = (nM - fm) < WGM ? (nM - fm) : WGM;
        u.pm = fm + ((wgid % nig) % gsz); u.pn = (wgid % nig) / gsz; return true;
    }
    __device__ __forceinline__ void a_ready(const Unit&) const {}
    __device__ __forceinline__ void done(const Unit&) const {}
};

template <class Epi, class Sched, bool ALIGN_EPI = false, bool SP2 = false>
__device__ __forceinline__ void gemm_phase(PG8_LAS unsigned char* lds, const Gemm g, const Sched& S, const Epi& E) {
    int tid_ = threadIdx.x; asm volatile("" : "+v"(tid_));
    const int tid = tid_, wid = __builtin_amdgcn_readfirstlane(tid >> 6), lane = tid & 63, wr = wid >> 2, wc = wid & 3, fr = lane & 15, fq = lane >> 4;
    const int K = g.K, nt = K / BK;
    unsigned voffA[2], voffB[2];
#pragma unroll
    for (int i = 0; i < 2; ++i) { int R, C; stage_rc(tid * 16 + i * 8192, R, C); const int Rb = Epi::PERM ? ((R & ~31) + perm32(R & 31)) : R;
        voffA[i] = (unsigned)(R * K + C) * 2u; voffB[i] = (unsigned)(Rb * K + C) * 2u; }
    const size_t kstep = (size_t)(BK * 2);
    const size_t hstep = (size_t)HALF * K * 2;
    const size_t tstep = 2 * hstep;
    const unsigned ldsw = (unsigned)wid * 1024u;
    const int aoff = lds_byte(wr * 64 + fr, fq * 8), boff = lds_byte(wc * 32 + fr, fq * 8);
#define PG8_SA(b, h) (((b) * 2 + (h)) * HTB)
#define PG8_SB(b, h) ((4 + (b) * 2 + (h)) * HTB)
#define PG8_STAGE(bufoff, gbase, voff) do { _Pragma("unroll") for (int _i = 0; _i < 2; ++_i) \
        __builtin_amdgcn_global_load_lds((const unsigned*)((const char*)(gbase) + (voff)[_i]), (PG8_LAS unsigned*)(lds + (bufoff) + ldsw + _i * 8192), 16, 0, 0); } while (0)
#define PG8_LDA(dst, b, h) do { _Pragma("unroll") for (int m = 0; m < 4; ++m) _Pragma("unroll") for (int k = 0; k < 2; ++k) dst[m][k] = *(const PG8_LAS bf16x8*)(lds + PG8_SA(b, h) + aoff + m * 2048 + k * 1024); } while (0)
#define PG8_LDB(dst, b, h) do { _Pragma("unroll") for (int n = 0; n < 2; ++n) _Pragma("unroll") for (int k = 0; k < 2; ++k) dst[n][k] = *(const PG8_LAS bf16x8*)(lds + PG8_SB(b, h) + boff + n * 2048 + k * 1024); } while (0)
#define PG8_MMA(ai, bj, At, Bt) do { __builtin_amdgcn_s_setprio(1); _Pragma("unroll") for (int m = 0; m < 4; ++m) _Pragma("unroll") for (int n = 0; n < 2; ++n) _Pragma("unroll") for (int k = 0; k < 2; ++k) \
        acc[ai][bj][m][n] = __builtin_amdgcn_mfma_f32_16x16x32_bf16(Bt[n][k], At[m][k], acc[ai][bj][m][n], 0, 0, 0); __builtin_amdgcn_s_setprio(0); } while (0)
#define PG8_WAIT_V(n) asm volatile("s_waitcnt vmcnt(" #n ")" ::: "memory")
#define PG8_WAIT_L(n) asm volatile("s_waitcnt lgkmcnt(" #n ")" ::: "memory")
#define PG8_BAR __builtin_amdgcn_s_barrier()
#define PG8_SCHED __builtin_amdgcn_sched_barrier(0)
    Unit cur, nxt; int ui = 0;
    if (!S.next(0, cur)) return;
    f32x4 acc[2][2][4][2];
#pragma unroll
    for (int a = 0; a < 2; ++a)
#pragma unroll
        for (int b = 0; b < 2; ++b)
#pragma unroll
            for (int m = 0; m < 4; ++m)
#pragma unroll
                for (int n = 0; n < 2; ++n) acc[a][b][m][n] = (f32x4){0.f, 0.f, 0.f, 0.f};
    bf16x8 At[4][2], B0[2][2], B1[2][2];
    const char* cA = (const char*)g.A + (size_t)cur.pm * tstep; const char* cB = (const char*)g.Bt + (size_t)cur.pn * tstep;
    S.a_ready(cur);
    if constexpr (SP2) {
        PG8_STAGE(PG8_SB(0, 0), cB, voffB); PG8_STAGE(PG8_SB(0, 1), cB + hstep, voffB); PG8_STAGE(PG8_SA(0, 0), cA, voffA); PG8_STAGE(PG8_SA(0, 1), cA + hstep, voffA);
        if (wr == 1) PG8_BAR;
        PG8_WAIT_V(2); PG8_BAR;
        PG8_STAGE(PG8_SB(1, 0), cB + kstep, voffB); PG8_STAGE(PG8_SA(1, 0), cA + kstep, voffA); PG8_STAGE(PG8_SB(1, 1), cB + hstep + kstep, voffB);
        PG8_WAIT_V(6); PG8_BAR;
    } else {
        PG8_STAGE(PG8_SB(0, 0), cB, voffB); PG8_STAGE(PG8_SA(0, 0), cA, voffA); PG8_STAGE(PG8_SB(0, 1), cB + hstep, voffB); PG8_STAGE(PG8_SA(0, 1), cA + hstep, voffA);
        if (wr == 1) PG8_BAR;
        PG8_WAIT_V(4); PG8_BAR;
        PG8_STAGE(PG8_SB(1, 0), cB + kstep, voffB); PG8_STAGE(PG8_SA(1, 0), cA + kstep, voffA); PG8_STAGE(PG8_SB(1, 1), cB + hstep + kstep, voffB);
        PG8_WAIT_V(6); PG8_BAR;
    }
    for (;;) {
        const bool has_next = S.next(ui + 1, nxt);
        const char* nA = has_next ? (const char*)g.A + (size_t)nxt.pm * tstep : cA; const char* nB = has_next ? (const char*)g.Bt + (size_t)nxt.pn * tstep : cB;
        for (int t = 0; t < nt; t += 2) {
            const bool last = (t == nt - 2);
            const char* a1 = cA + (size_t)(t + 1) * kstep;
            const char* a2 = last ? nA : cA + (size_t)(t + 2) * kstep; const char* b2 = last ? nB : cB + (size_t)(t + 2) * kstep;
            const char* a3 = a2 + kstep; const char* b3 = b2 + kstep;
            if (last && has_next) S.a_ready(nxt);
            if constexpr (SP2) {
            PG8_LDB(B0, 0, 0); PG8_LDB(B1, 0, 1); PG8_SCHED; PG8_LDA(At, 0, 0); PG8_STAGE(PG8_SA(1, 1), a1 + hstep, voffA);
            PG8_WAIT_V(8); PG8_WAIT_L(0); PG8_BAR; PG8_MMA(0, 0, At, B0); PG8_MMA(0, 1, At, B1); PG8_BAR; PG8_SCHED;
            PG8_LDA(At, 0, 1); PG8_STAGE(PG8_SB(0, 0), b2, voffB); PG8_STAGE(PG8_SB(0, 1), b2 + hstep, voffB); PG8_STAGE(PG8_SA(0, 0), a2, voffA);
            PG8_WAIT_V(8); PG8_WAIT_L(0); PG8_BAR; PG8_MMA(1, 0, At, B0); PG8_MMA(1, 1, At, B1); PG8_BAR; PG8_SCHED;
            PG8_LDB(B0, 1, 0); PG8_LDB(B1, 1, 1); PG8_SCHED; PG8_LDA(At, 1, 0); PG8_STAGE(PG8_SA(0, 1), a2 + hstep, voffA);
            PG8_WAIT_V(8); PG8_WAIT_L(0); PG8_BAR; PG8_MMA(0, 0, At, B0); PG8_MMA(0, 1, At, B1); PG8_BAR; PG8_SCHED;
            PG8_LDA(At, 1, 1); PG8_STAGE(PG8_SB(1, 0), b3, voffB); PG8_STAGE(PG8_SB(1, 1), b3 + hstep, voffB); PG8_STAGE(PG8_SA(1, 0), a3, voffA);
            PG8_WAIT_V(8); PG8_WAIT_L(0); PG8_BAR; PG8_MMA(1, 0, At, B0); PG8_MMA(1, 1, At, B1); PG8_BAR; PG8_SCHED;
            } else {
            PG8_LDB(B0, 0, 0); PG8_SCHED; PG8_LDA(At, 0, 0); PG8_STAGE(PG8_SA(1, 1), a1 + hstep, voffA);
            PG8_WAIT_L(8); PG8_BAR; PG8_WAIT_L(0); PG8_MMA(0, 0, At, B0); PG8_BAR; PG8_SCHED;
            PG8_LDB(B1, 0, 1); PG8_STAGE(PG8_SB(0, 0), b2, voffB);
            PG8_BAR; PG8_WAIT_L(0); PG8_MMA(0, 1, At, B1); PG8_BAR;
            PG8_LDA(At, 0, 1); PG8_STAGE(PG8_SA(0, 0), a2, voffA);
            PG8_BAR; PG8_WAIT_L(0); PG8_MMA(1, 0, At, B0); PG8_BAR; PG8_SCHED;
            PG8_STAGE(PG8_SB(0, 1), b2 + hstep, voffB);
            PG8_WAIT_V(6); PG8_BAR; PG8_MMA(1, 1, At, B1); PG8_BAR;
            PG8_LDB(B0, 1, 0); PG8_SCHED; PG8_LDA(At, 1, 0); PG8_STAGE(PG8_SA(0, 1), a2 + hstep, voffA);
            PG8_WAIT_L(8); PG8_BAR; PG8_WAIT_L(0); PG8_MMA(0, 0, At, B0); PG8_BAR; PG8_SCHED;
            PG8_LDB(B1, 1, 1); PG8_STAGE(PG8_SB(1, 0), b3, voffB);
            PG8_BAR; PG8_WAIT_L(0); PG8_MMA(0, 1, At, B1); PG8_BAR;
            PG8_LDA(At, 1, 1); PG8_STAGE(PG8_SA(1, 0), a3, voffA);
            PG8_BAR; PG8_WAIT_L(0); PG8_MMA(1, 0, At, B0); PG8_BAR; PG8_SCHED;
            PG8_STAGE(PG8_SB(1, 1), b3 + hstep, voffB);
            PG8_WAIT_V(6); PG8_BAR; PG8_MMA(1, 1, At, B1); PG8_BAR;
            }
        }
        if constexpr (ALIGN_EPI) { if (wr == 0) PG8_BAR; }
        if constexpr (!Epi::AFTER_DRAIN) { E(acc, cur, wr, wc, fr, fq); S.done(cur); }
        if (!has_next) break;
#pragma unroll
        for (int a = 0; a < 2; ++a)
#pragma unroll
            for (int b = 0; b < 2; ++b)
#pragma unroll
                for (int m = 0; m < 4; ++m)
#pragma unroll
                    for (int n = 0; n < 2; ++n) acc[a][b][m][n] = (f32x4){0.f, 0.f, 0.f, 0.f};
        cur = nxt; cA = nA; cB = nB; ++ui;
        if constexpr (ALIGN_EPI) { if (wr == 1) PG8_BAR; }
    }
    PG8_WAIT_V(0);
    if constexpr (!ALIGN_EPI) { if (wr == 0) PG8_BAR; }
    PG8_BAR;
    if constexpr (Epi::AFTER_DRAIN) { E.fused(acc, cur, wr, wc, fr, fq, lds, wid, lane); S.done(cur); }
#undef PG8_SA
#undef PG8_SB
#undef PG8_STAGE
#undef PG8_LDA
#undef PG8_LDB
#undef PG8_MMA
#undef PG8_WAIT_V
#undef PG8_WAIT_L
#undef PG8_BAR
#undef PG8_SCHED
}
}

constexpr int NWAVES = 8;
constexpr int D = 1024, FF = 2816, NIN = 3584, MP = 16384, MS = 256, M = MP + MS, SEQ = 4096;
constexpr int SEG_Q = 0, SEG_K = 512, SEG_V = 1024, SEG_BQ = 1536, SEG_BF = 2048, SEG_BI = 2560, SEG_BG = 3072;
constexpr float EPS = 1e-6f;
constexpr size_t OFF_Y = 0, OFF_KP = 17039360, OFF_VP = 25427968, OFF_SP = 33816576, OFF_KS = 34340864, OFF_VS = 34603008, OFF_SS = 34865152;
constexpr size_t MiB = 1u << 20;
constexpr size_t WS_LB = 0;
constexpr size_t WS_W = 1 * MiB;
constexpr size_t W_G1 = 0, W_D1 = W_G1 + (size_t)2 * FF * D, W_IN = W_D1 + (size_t)D * FF, W_OUT = W_IN + (size_t)NIN * D,
                 W_G2 = W_OUT + (size_t)D * D, W_D2 = W_G2 + (size_t)2 * FF * D, W_LAYER = W_D2 + (size_t)D * FF;
constexpr size_t WS_XN = WS_W + 2 * W_LAYER * 2;
constexpr size_t WS_O = WS_XN + (size_t)M * D * 2;
constexpr size_t WS_HID = WS_O + (size_t)M * D * 2;
constexpr size_t WS_Y = WS_HID + (size_t)M * FF * 2;
constexpr size_t WS_H = WS_Y + (size_t)M * D * 4;
constexpr size_t WS_Z = WS_H + (size_t)M * D * 4;
constexpr size_t WS_OA = WS_Z + (size_t)M * NIN * 4;
constexpr size_t WS_OH = WS_OA + (size_t)M * 512 * 4;
constexpr size_t WS_END = WS_OH + (size_t)M * 512 * 4;
constexpr int LDS_BYTES = 147456;

#define GAS __attribute__((address_space(1)))
#define LAS __attribute__((address_space(3)))
typedef unsigned short bf16;
typedef unsigned v4u __attribute__((ext_vector_type(4)));
typedef float f32x4 __attribute__((ext_vector_type(4)));
#define LDS_WAIT() asm volatile("s_waitcnt lgkmcnt(0)" ::: "memory")

__device__ __forceinline__ unsigned f2bf(float f) { unsigned u = __builtin_bit_cast(unsigned, f); return (u + 0x7fffu + ((u >> 16) & 1u)) >> 16; }
__device__ __forceinline__ unsigned pk2(float lo, float hi) { return f2bf(lo) | (f2bf(hi) << 16); }
__device__ __forceinline__ float silu_f(float x) { return x * __frcp_rn(1.f + __expf(-x)); }
__device__ __forceinline__ float sigmoid_f(float x) { return __frcp_rn(1.f + __expf(-x)); }
__device__ __forceinline__ float wave_sum(float v) {
#pragma unroll
    for (int o = 1; o < 64; o <<= 1) v += __shfl_xor(v, o);
    return v;
}
__device__ __forceinline__ float wave_max(float v) {
#pragma unroll
    for (int o = 1; o < 64; o <<= 1) v = fmaxf(v, __shfl_xor(v, o));
    return v;
}

struct EpiSwiglu {
    static constexpr bool PERM = true, AFTER_DRAIN = false;
    bf16* H;
    __device__ __forceinline__ void operator()(const pg8::f32x4 (&acc)[2][2][4][2], const pg8::Unit& u, int wr, int wc, int fr, int fq) const {
        const int row0 = u.pm * 256 + wr * 64 + fr, col0 = u.pn * 128 + wc * 32 + 8 * fq;
#pragma unroll
        for (int ai = 0; ai < 2; ++ai)
#pragma unroll
            for (int m = 0; m < 4; ++m) {
                bf16* rowp = H + (size_t)(row0 + ai * 128 + m * 16) * FF + col0;
                const pg8::f32x4 g0 = acc[ai][0][m][0], g1 = acc[ai][0][m][1], u0 = acc[ai][1][m][0], u1 = acc[ai][1][m][1];
                v4u w;
                w.x = pk2(silu_f(g0[0]) * u0[0], silu_f(g0[1]) * u0[1]); w.y = pk2(silu_f(g0[2]) * u0[2], silu_f(g0[3]) * u0[3]);
                w.z = pk2(silu_f(g1[0]) * u1[0], silu_f(g1[1]) * u1[1]); w.w = pk2(silu_f(g1[2]) * u1[2], silu_f(g1[3]) * u1[3]);
                *(v4u*)rowp = w;
            }
    }
};
struct EpiF32 {
    static constexpr bool PERM = true, AFTER_DRAIN = false;
    float* Y; int ldc;
    __device__ __forceinline__ void operator()(const pg8::f32x4 (&acc)[2][2][4][2], const pg8::Unit& u, int wr, int wc, int fr, int fq) const {
        const int row0 = u.pm * 256 + wr * 64 + fr, col0 = u.pn * 256 + wc * 32 + 8 * fq;
#pragma unroll
        for (int ai = 0; ai < 2; ++ai)
#pragma unroll
            for (int m = 0; m < 4; ++m) {
                float* rowp = Y + (size_t)(row0 + ai * 128 + m * 16) * ldc + col0;
#pragma unroll
                for (int bj = 0; bj < 2; ++bj)
#pragma unroll
                    for (int n = 0; n < 2; ++n) *(f32x4*)(rowp + bj * 128 + 4 * n) = acc[ai][bj][m][n];
            }
    }
};
struct EpiMix {
    static constexpr bool PERM = true, AFTER_DRAIN = false;
    float* Z; const float* lb; float* out; int l;
    __device__ __forceinline__ void operator()(const pg8::f32x4 (&acc)[2][2][4][2], const pg8::Unit& u, int wr, int wc, int fr, int fq) const {
        const int seg = u.pn >> 1;
        const int row0 = u.pm * 256 + wr * 64 + fr, cs0 = (u.pn & 1) * 256 + wc * 32 + 8 * fq;
        f32x4 lbv[2][2];
#pragma unroll
        for (int bj = 0; bj < 2; ++bj)
#pragma unroll
            for (int n = 0; n < 2; ++n) lbv[bj][n] = (seg == 4) ? *(const f32x4*)(lb + cs0 + bj * 128 + 4 * n) : (f32x4){0.f, 0.f, 0.f, 0.f};
#pragma unroll
        for (int ai = 0; ai < 2; ++ai)
#pragma unroll
            for (int m = 0; m < 4; ++m) {
                const int row = row0 + ai * 128 + m * 16;
                float* zrow = Z + (size_t)row * NIN + seg * 512 + cs0;
                float* orow = nullptr;
                if (seg == 1 || seg == 2) {
                    if (row < MP) { const int b = row >> 12, t = row & 4095;
                        if (t >= 2048) orow = out + (seg == 1 ? OFF_KP : OFF_VP) + ((size_t)(l * 4 + b) * 2048 + (t - 2048)) * 512 + cs0; }
                    else orow = out + (seg == 1 ? OFF_KS : OFF_VS) + ((size_t)l * 256 + (row - MP)) * 512 + cs0;
                }
#pragma unroll
                for (int bj = 0; bj < 2; ++bj)
#pragma unroll
                    for (int n = 0; n < 2; ++n) {
                        f32x4 v = acc[ai][bj][m][n];
                        if (seg == 0) v = v * 0.125f;
                        else if (seg == 3 || seg == 6) { v[0] = silu_f(v[0]); v[1] = silu_f(v[1]); v[2] = silu_f(v[2]); v[3] = silu_f(v[3]); }
                        else if (seg == 4) {
                            const f32x4 b4 = lbv[bj][n];
#pragma unroll
                            for (int i = 0; i < 4; ++i) v[i] = b4[i] + (1.f - b4[i]) * sigmoid_f(v[i]);
                        }
                        *(f32x4*)(zrow + bj * 128 + 4 * n) = v;
                        if (orow) *(f32x4*)(orow + bj * 128 + 4 * n) = v;
                    }
            }
    }
};

__device__ __forceinline__ void p0_transpose_item(const float* W, int K, int N, bf16* WT, int mode, LAS float* scr, int item, int lane) {
    const int nblk = N / 32, kb = item / nblk, nb = item % nblk, k0 = 64 * kb, n0 = 32 * nb;
    const int r0 = (mode == 0) ? n0 : ((n0 >> 7) * 256 + (mode - 1) * 128 + (n0 & 127));
#pragma unroll 8
    for (int i = 0; i < 32; ++i) { const int kk = 2 * i + (lane >> 5); scr[kk * 33 + (lane & 31)] = W[(size_t)(k0 + kk) * N + n0 + (lane & 31)]; }
    LDS_WAIT(); asm volatile("" ::: "memory");
    const int c = lane & 7;
#pragma unroll
    for (int j = 0; j < 4; ++j) { const int n = (lane >> 3) + 8 * j; const LAS float* s = scr + (8 * c) * 33 + n;
        v4u o; o.x = pk2(s[0 * 33], s[1 * 33]); o.y = pk2(s[2 * 33], s[3 * 33]); o.z = pk2(s[4 * 33], s[5 * 33]); o.w = pk2(s[6 * 33], s[7 * 33]);
        *(v4u*)(WT + (size_t)(r0 + n) * K + k0 + 8 * c) = o; }
    LDS_WAIT(); asm volatile("" ::: "memory");
}

template <bool HAS_Y>
__device__ __forceinline__ void row_phase(const float* res_p, const float* res_s  , const float* Y, const float* post_g, float coef,
                                          float* hout, const float* pre_g, bf16* xn, int gw, int NGW, int lane) {
    for (int row = gw; row < M; row += NGW) {
        const float* rp = (res_s && row >= MP) ? res_s + (size_t)(row - MP) * D : res_p + (size_t)row * D;
        f32x4 v[4];
#pragma unroll
        for (int j = 0; j < 4; ++j) v[j] = *((const f32x4*)rp + lane + 64 * j);
        if (HAS_Y) {
            f32x4 y[4]; float s = 0.f;
#pragma unroll
            for (int j = 0; j < 4; ++j) { y[j] = *((const f32x4*)(Y + (size_t)row * D) + lane + 64 * j); s += (y[j][0] * y[j][0] + y[j][1] * y[j][1]) + (y[j][2] * y[j][2] + y[j][3] * y[j][3]); }
            const float rstd = coef * rsqrtf(wave_sum(s) * (1.f / D) + EPS);
#pragma unroll
            for (int j = 0; j < 4; ++j) { const f32x4 g = *((const f32x4*)post_g + lane + 64 * j); v[j] = v[j] + y[j] * g * rstd; }
        }
        if (hout) {
#pragma unroll
            for (int j = 0; j < 4; ++j) *((f32x4*)(hout + (size_t)row * D) + lane + 64 * j) = v[j];
        }
        if (pre_g) {
            float s = 0.f;
#pragma unroll
            for (int j = 0; j < 4; ++j) s += (v[j][0] * v[j][0] + v[j][1] * v[j][1]) + (v[j][2] * v[j][2] + v[j][3] * v[j][3]);
            const float rstd = rsqrtf(wave_sum(s) * (1.f / D) + EPS);
            unsigned long long* o8 = (unsigned long long*)(xn + (size_t)row * D) + lane;
#pragma unroll
            for (int j = 0; j < 4; ++j) { const f32x4 g = *((const f32x4*)pre_g + lane + 64 * j); const f32x4 w = v[j] * g * rstd;
                o8[64 * j] = (unsigned long long)pk2(w[0], w[1]) | ((unsigned long long)pk2(w[2], w[3]) << 32); }
        }
    }
}

__device__ __forceinline__ void r3_phase(const float* OA, const float* OH, const float* Z, const float* attn_g, const float* hgrn_g, bf16* O, int gw, int NGW, int lane) {
    for (int row = gw; row < M; row += NGW) {
        const f32x4 a0 = *((const f32x4*)(OA + (size_t)row * 512) + 2 * lane), a1 = *((const f32x4*)(OA + (size_t)row * 512) + 2 * lane + 1);
        const f32x4 h0 = *((const f32x4*)(OH + (size_t)row * 512) + 2 * lane), h1 = *((const f32x4*)(OH + (size_t)row * 512) + 2 * lane + 1);
        const f32x4 g0 = *((const f32x4*)(Z + (size_t)row * NIN + SEG_BG) + 2 * lane), g1 = *((const f32x4*)(Z + (size_t)row * NIN + SEG_BG) + 2 * lane + 1);
        float sa = (a0[0] * a0[0] + a0[1] * a0[1]) + (a0[2] * a0[2] + a0[3] * a0[3]) + (a1[0] * a1[0] + a1[1] * a1[1]) + (a1[2] * a1[2] + a1[3] * a1[3]);
        float sh = (h0[0] * h0[0] + h0[1] * h0[1]) + (h0[2] * h0[2] + h0[3] * h0[3]) + (h1[0] * h1[0] + h1[1] * h1[1]) + (h1[2] * h1[2] + h1[3] * h1[3]);
        sa = wave_sum(sa);
#pragma unroll
        for (int o = 1; o < 16; o <<= 1) sh += __shfl_xor(sh, o);
        const float ra = rsqrtf(sa * (1.f / 512.f) + EPS), rh = rsqrtf(sh * (1.f / 128.f) + EPS);
        const f32x4 ag0 = *((const f32x4*)attn_g + 2 * lane), ag1 = *((const f32x4*)attn_g + 2 * lane + 1);
        const f32x4 hg0 = *((const f32x4*)hgrn_g + 2 * (lane & 15)), hg1 = *((const f32x4*)hgrn_g + 2 * (lane & 15) + 1);
        const f32x4 oa0 = a0 * ag0 * ra, oa1 = a1 * ag1 * ra, ob0 = h0 * hg0 * rh * g0, ob1 = h1 * hg1 * rh * g1;
        v4u wa, wb;
        wa.x = pk2(oa0[0], oa0[1]); wa.y = pk2(oa0[2], oa0[3]); wa.z = pk2(oa1[0], oa1[1]); wa.w = pk2(oa1[2], oa1[3]);
        wb.x = pk2(ob0[0], ob0[1]); wb.y = pk2(ob0[2], ob0[3]); wb.z = pk2(ob1[0], ob1[1]); wb.w = pk2(ob1[2], ob1[3]);
        *((v4u*)(O + (size_t)row * D) + lane) = wa;
        *((v4u*)(O + (size_t)row * D + 512) + lane) = wb;
    }
}

struct HgIn { f32x4 f0, f1, q0, q1; float v; };
__device__ __forceinline__ void hg_load(HgIn (&d)[4], const float* Z, int rowbase, int t0, int T, int h, int kq, int vcol) {
#pragma unroll
    for (int i = 0; i < 4; ++i) {
        int t = t0 + i; t = t < T ? t : T - 1;
        const float* zr = Z + (size_t)(rowbase + t) * NIN + h * 128;
        d[i].f0 = *(const f32x4*)(zr + SEG_BF + kq * 8); d[i].f1 = *(const f32x4*)(zr + SEG_BF + kq * 8 + 4);
        d[i].q0 = *(const f32x4*)(zr + SEG_BQ + kq * 8); d[i].q1 = *(const f32x4*)(zr + SEG_BQ + kq * 8 + 4);
        d[i].v = zr[SEG_BI + vcol];
    }
}
__device__ __forceinline__ void hg_step4(const HgIn (&d)[4], float (&S)[8], float* OH, int rowbase, int t0, int h, int kq, int vcol) {
#pragma unroll
    for (int i = 0; i < 4; ++i) {
        const float vv = d[i].v; float acc = 0.f;
#pragma unroll
        for (int k = 0; k < 4; ++k) { S[k] = fmaf(d[i].f0[k], S[k] - vv, vv); acc = fmaf(d[i].q0[k], S[k], acc); }
#pragma unroll
        for (int k = 0; k < 4; ++k) { S[4 + k] = fmaf(d[i].f1[k], S[4 + k] - vv, vv); acc = fmaf(d[i].q1[k], S[4 + k], acc); }
#pragma unroll
        for (int o = 1; o < 16; o <<= 1) acc += __shfl_xor(acc, o);
        if (kq == 0) OH[(size_t)(rowbase + t0 + i) * 512 + h * 128 + vcol] = acc;
    }
}
__device__ __forceinline__ void hgrn_task(const float* Z, float* OH, const float* s0, float* sout, int rowbase, int T, int h, int vg, int lane) {
    const int kq = lane & 15, vcol = vg * 4 + (lane >> 4);
    float S[8];
#pragma unroll
    for (int k = 0; k < 8; ++k) S[k] = s0 ? s0[(size_t)(kq * 8 + k) * 128 + vcol] : 0.f;
    HgIn A[4], B[4];
    hg_load(A, Z, rowbase, 0, T, h, kq, vcol);
    for (int t0 = 0; t0 < T; t0 += 8) {
        hg_load(B, Z, rowbase, t0 + 4, T, h, kq, vcol);
        hg_step4(A, S, OH, rowbase, t0, h, kq, vcol);
        hg_load(A, Z, rowbase, t0 + 8, T, h, kq, vcol);
        hg_step4(B, S, OH, rowbase, t0 + 4, h, kq, vcol);
    }
#pragma unroll
    for (int k = 0; k < 8; ++k) sout[(size_t)(kq * 8 + k) * 128 + vcol] = S[k];
}

__device__ __forceinline__ const float* kv_ptr(bool samp, int b, int idx, int h, int seg, const float* Z, const float* cache, int l) {
    if (!samp) return Z + (size_t)(b * SEQ + idx) * NIN + seg + h * 64;
    if (idx >= 2048) return Z + (size_t)(MP + b * 8 + (idx - 2048)) * NIN + seg + h * 64;
    return cache + ((((size_t)l * 32 + b) * 2048 + idx) * 8 + h) * 64;
}
__device__ __forceinline__ float dot64(const f32x4 (&q)[16], const float* kp) {
    float a0 = 0.f, a1 = 0.f, a2 = 0.f, a3 = 0.f;
#pragma unroll
    for (int i = 0; i < 16; ++i) { const f32x4 k = *((const f32x4*)kp + i); a0 = fmaf(q[i][0], k[0], a0); a1 = fmaf(q[i][1], k[1], a1); a2 = fmaf(q[i][2], k[2], a2); a3 = fmaf(q[i][3], k[3], a3); }
    return (a0 + a1) + (a2 + a3);
}
__device__ __forceinline__ v4u aent(float c, const float* p) { v4u e; e.x = __builtin_bit_cast(unsigned, c); e.y = 0u; const unsigned long long a = (unsigned long long)p; e.z = (unsigned)a; e.w = (unsigned)(a >> 32); return e; }
__device__ __forceinline__ void attn_item(int row, int h, int l, const float* Z, const float* ck, const float* cv, float* OA, LAS v4u* scr, int lane) {
    const bool samp = row >= MP;
    int b, pos;
    if (!samp) { b = row >> 12; pos = row & 4095; } else { const int r = row - MP; b = r >> 3; pos = 2048 + (r & 7); }
    float s0;
    {
        const float* qp = Z + (size_t)row * NIN + SEG_Q + h * 64;
        f32x4 q[16];
#pragma unroll
        for (int i = 0; i < 16; ++i) q[i] = *((const f32x4*)qp + i);
        s0 = dot64(q, kv_ptr(samp, b, pos, h, SEG_K, Z, ck, l));
#pragma unroll 1
        for (int ph = 0; ph < 6; ++ph) {
            const int d = 1 << (2 * (ph >> 1));
            const int j = 1 + (ph & 1) * 64 + lane; const int idx = pos - d * j; const bool valid = idx >= 0; const int ic = valid ? idx : pos;
            const float sdot = dot64(q, kv_ptr(samp, b, ic, h, SEG_K, Z, ck, l));
            scr[1 + ph * 64 + lane] = aent(valid ? sdot : -INFINITY, kv_ptr(samp, b, ic, h, SEG_V, Z, cv, l));
        }
    }
    const float* vself = kv_ptr(samp, b, pos, h, SEG_V, Z, cv, l);
    __builtin_amdgcn_wave_barrier(); LDS_WAIT();
    float sc[3][2], lse[3], e0[3], w[3];
#pragma unroll
    for (int p = 0; p < 3; ++p) {
        sc[p][0] = __builtin_bit_cast(float, scr[1 + p * 128 + lane].x); sc[p][1] = __builtin_bit_cast(float, scr[1 + p * 128 + 64 + lane].x);
        const float m = fmaxf(s0, wave_max(fmaxf(sc[p][0], sc[p][1])));
        sc[p][0] = __expf(sc[p][0] - m); sc[p][1] = __expf(sc[p][1] - m); e0[p] = __expf(s0 - m);
        const float lsum = e0[p] + wave_sum(sc[p][0] + sc[p][1]);
        lse[p] = m + __logf(lsum); w[p] = 1.f / lsum;
    }
    const float mx = fmaxf(lse[0], fmaxf(lse[1], lse[2]));
    const float x0 = __expf(lse[0] - mx), x1 = __expf(lse[1] - mx), x2 = __expf(lse[2] - mx);
    const float iw = 1.f / (x0 + x1 + x2);
    w[0] *= x0 * iw; w[1] *= x1 * iw; w[2] *= x2 * iw;
    const float cself = w[0] * e0[0] + w[1] * e0[1] + w[2] * e0[2];
#pragma unroll
    for (int p = 0; p < 3; ++p) { scr[1 + p * 128 + lane].x = __builtin_bit_cast(unsigned, w[p] * sc[p][0]); scr[1 + p * 128 + 64 + lane].x = __builtin_bit_cast(unsigned, w[p] * sc[p][1]); }
    if (lane < 4) scr[lane == 0 ? 0 : 384 + lane] = aent(lane == 0 ? cself : 0.f, vself);
    __builtin_amdgcn_wave_barrier(); LDS_WAIT();
    const int ks = lane >> 4, c4 = (lane & 15) * 4;
    f32x4 acc = {0.f, 0.f, 0.f, 0.f};
#pragma unroll 4
    for (int i = 0; i < 97; ++i) { const v4u e = scr[4 * i + ks]; const float* vp = (const float*)(((unsigned long long)e.w << 32) | e.z);
        const f32x4 v = *(const f32x4*)(vp + c4); acc = acc + v * __builtin_bit_cast(float, e.x); }
#pragma unroll
    for (int i = 0; i < 4; ++i) { acc[i] += __shfl_xor(acc[i], 16); acc[i] += __shfl_xor(acc[i], 32); }
    if (lane < 16) *(f32x4*)(OA + (size_t)row * 512 + h * 64 + c4) = acc;
    __builtin_amdgcn_wave_barrier(); LDS_WAIT();
}

struct Args { const float* in[22]; float* out; unsigned char* ws; int ph_lo, ph_hi; };
constexpr int N_PHASES = 23;

__global__ void __launch_bounds__(NWAVES * 64, 2) mk_fwd(Args args) {
    extern __shared__ __attribute__((aligned(16))) unsigned char lds_raw[];
    LAS unsigned char* lds = (LAS unsigned char*)lds_raw;
    const int G = gridDim.x, bx = blockIdx.x, NGW = G * NWAVES;
#define FRESH() int tid_ = threadIdx.x; asm volatile("" : "+v"(tid_)); const int tid = tid_, lane = tid & 63, wave = __builtin_amdgcn_readfirstlane(tid >> 6), gw = bx * NWAVES + wave; (void)tid; (void)lane; (void)gw;
    unsigned char* ws = args.ws;
    float* LB = (float*)(ws + WS_LB);
    bf16* Wb = (bf16*)(ws + WS_W);
    bf16* XN = (bf16*)(ws + WS_XN); bf16* OB = (bf16*)(ws + WS_O); bf16* HID = (bf16*)(ws + WS_HID);
    float* Y = (float*)(ws + WS_Y); float* HR = (float*)(ws + WS_H); float* Z = (float*)(ws + WS_Z);
    float* OA = (float*)(ws + WS_OA); float* OH = (float*)(ws + WS_OH);
    float* out = args.out;
    const int lo = args.ph_lo, hi = args.ph_hi;
#define IN(k) (lo <= (k) && (k) < hi)
#define SEAM(k) do { if (IN(k) && IN((k) + 1)) cg::this_grid().sync(); } while (0)

    if (IN(0)) {
        FRESH();
        LAS float* scr = (LAS float*)(lds + wave * 16384);
        constexpr int I_FF = (D / 64) * (FF / 32), I_DN = (FF / 64) * (D / 32), I_IN = (D / 64) * (NIN / 32), I_OUT = (D / 64) * (D / 32);
        constexpr int I_LAYER = 4 * I_FF + 2 * I_DN + I_IN + I_OUT;
        for (int it = gw; it < 2 * I_LAYER; it += NGW) {
            const int l = it / I_LAYER; int r = it % I_LAYER;
            bf16* wl = Wb + (size_t)l * W_LAYER;
            if (r < I_FF) { p0_transpose_item(args.in[6] + (size_t)l * D * FF, D, FF, wl + W_G1, 1, scr, r, lane); continue; } r -= I_FF;
            if (r < I_FF) { p0_transpose_item(args.in[7] + (size_t)l * D * FF, D, FF, wl + W_G1, 2, scr, r, lane); continue; } r -= I_FF;
            if (r < I_DN) { p0_transpose_item(args.in[8] + (size_t)l * D * FF, FF, D, wl + W_D1, 0, scr, r, lane); continue; } r -= I_DN;
            if (r < I_IN) { p0_transpose_item(args.in[11] + (size_t)l * D * NIN, D, NIN, wl + W_IN, 0, scr, r, lane); continue; } r -= I_IN;
            if (r < I_OUT) { p0_transpose_item(args.in[15] + (size_t)l * D * D, D, D, wl + W_OUT, 0, scr, r, lane); continue; } r -= I_OUT;
            if (r < I_FF) { p0_transpose_item(args.in[18] + (size_t)l * D * FF, D, FF, wl + W_G2, 1, scr, r, lane); continue; } r -= I_FF;
            if (r < I_FF) { p0_transpose_item(args.in[19] + (size_t)l * D * FF, D, FF, wl + W_G2, 2, scr, r, lane); continue; } r -= I_FF;
            p0_transpose_item(args.in[20] + (size_t)l * D * FF, FF, D, wl + W_D2, 0, scr, r, lane);
        }
        if (bx == 0) {
            const float* lg = args.in[13];
            const float x0 = lg[tid], x1 = lg[512 + tid];
            LB[tid] = 0.f; LB[512 + tid] = 1.f / (1.f + __expf(x0 - x1));
        }
        row_phase<false>(args.in[0], args.in[1], nullptr, nullptr, 0.f, nullptr, args.in[5], XN, gw, NGW, lane);
    }
    SEAM(0);

#pragma unroll 1
    for (int l = 0; l < 2; ++l) {
        const int pb = 1 + 11 * l;
        const bf16* wl = Wb + (size_t)l * W_LAYER;
        if (IN(pb + 0)) {
            pg8::Gemm g{XN, wl + W_G1, M, 2 * FF, D}; pg8::StaticOrder S; S.init(M, 2 * FF, G, bx);
            EpiSwiglu E{HID};
            pg8::gemm_phase<EpiSwiglu, pg8::StaticOrder, true, true>(lds, g, S, E);
        }
        SEAM(pb + 0);
        if (IN(pb + 1)) {
            pg8::Gemm g{HID, wl + W_D1, M, D, FF}; pg8::StaticOrder S; S.init(M, D, G, bx);
            EpiF32 E{Y, D};
            pg8::gemm_phase<EpiF32, pg8::StaticOrder, true, true>(lds, g, S, E);
        }
        SEAM(pb + 1);
        if (IN(pb + 2)) {
            FRESH();
            if (l == 0) row_phase<true>(args.in[0], args.in[1], Y, args.in[9] + l * D, 0.5f, HR, args.in[10] + l * D, XN, gw, NGW, lane);
            else        row_phase<true>(HR, nullptr, Y, args.in[9] + l * D, 0.5f, HR, args.in[10] + l * D, XN, gw, NGW, lane);
        }
        SEAM(pb + 2);
        if (IN(pb + 3)) {
            pg8::Gemm g{XN, wl + W_IN, M, NIN, D}; pg8::StaticOrder S; S.init(M, NIN, G, bx);
            EpiMix E{Z, LB + l * 512, out, l};
            pg8::gemm_phase<EpiMix, pg8::StaticOrder, true, true>(lds, g, S, E);
        }
        SEAM(pb + 3);
        if (IN(pb + 4)) {
            FRESH();
            if (wave < 2) {
                const int hw = bx * 2 + wave, NHW = G * 2;
                for (int task = hw; task < 512; task += NHW) {
                    const int seq = task >> 5, vg = task & 31, b = seq >> 2, h = seq & 3;
                    hgrn_task(Z, OH, nullptr, out + OFF_SP + ((size_t)(l * 4 + b) * 4 + h) * 16384, b * SEQ, SEQ, h, vg, lane);
                }
                for (int task = hw; task < 4096; task += NHW) {
                    const int b = task >> 7, h = (task >> 5) & 3, vg = task & 31;
                    const size_t so = ((size_t)(l * 32 + b) * 4 + h) * 16384;
                    hgrn_task(Z, OH, args.in[4] + so, out + OFF_SS + so, MP + b * 8, 8, h, vg, lane);
                }
            } else {
                LAS v4u* scr = (LAS v4u*)(lds + wave * 8192);
                const int aw = bx * 6 + (wave - 2), NAW = G * 6;
                const int NITEM = M * 8, per = (NITEM + NAW - 1) / NAW;
                const int i0 = aw * per, i1 = (i0 + per < NITEM) ? i0 + per : NITEM;
                for (int it = i0; it < i1; ++it) attn_item(it >> 3, it & 7, l, Z, args.in[2], args.in[3], OA, scr, lane);
            }
        }
        SEAM(pb + 4);
        if (IN(pb + 5)) { FRESH(); r3_phase(OA, OH, Z, args.in[12] + l * 512, args.in[14] + l * 128, OB, gw, NGW, lane); }
        SEAM(pb + 5);
        if (IN(pb + 6)) {
            pg8::Gemm g{OB, wl + W_OUT, M, D, D}; pg8::StaticOrder S; S.init(M, D, G, bx);
            EpiF32 E{Y, D};
            pg8::gemm_phase<EpiF32, pg8::StaticOrder, true, true>(lds, g, S, E);
        }
        SEAM(pb + 6);
        if (IN(pb + 7)) { FRESH(); row_phase<true>(HR, nullptr, Y, args.in[16] + l * D, 1.0f, HR, args.in[17] + l * D, XN, gw, NGW, lane); }
        SEAM(pb + 7);
        if (IN(pb + 8)) {
            pg8::Gemm g{XN, wl + W_G2, M, 2 * FF, D}; pg8::StaticOrder S; S.init(M, 2 * FF, G, bx);
            EpiSwiglu E{HID};
            pg8::gemm_phase<EpiSwiglu, pg8::StaticOrder, true, true>(lds, g, S, E);
        }
        SEAM(pb + 8);
        if (IN(pb + 9)) {
            pg8::Gemm g{HID, wl + W_D2, M, D, FF}; pg8::StaticOrder S; S.init(M, D, G, bx);
            EpiF32 E{Y, D};
            pg8::gemm_phase<EpiF32, pg8::StaticOrder, true, true>(lds, g, S, E);
        }
        SEAM(pb + 9);
        if (IN(pb + 10)) {
            FRESH();
            if (l == 0) row_phase<true>(HR, nullptr, Y, args.in[21] + l * D, 0.5f, HR, args.in[5] + D, XN, gw, NGW, lane);
            else        row_phase<true>(HR, nullptr, Y, args.in[21] + l * D, 0.5f, out + OFF_Y, nullptr, nullptr, gw, NGW, lane);
        }
        SEAM(pb + 10);
    }
#undef IN
#undef SEAM
}

extern "C" void kernel_launch(void* const* d_in, const int* in_sizes, int n_in, void* d_out, int out_size, void* d_ws, size_t ws_size, hipStream_t stream) {
    static int grid = 0;
    if (grid == 0) {
        if (n_in != 22 || ws_size < WS_END) { fprintf(stderr, "kernel_launch: n_in %d ws %zu (need %zu)\n", n_in, ws_size, (size_t)WS_END); grid = -1; return; }
        int dev = 0, cus = 0, per_cu = 0;
        (void)hipGetDevice(&dev);
        (void)hipDeviceGetAttribute(&cus, hipDeviceAttributeMultiprocessorCount, dev);
        if (hipFuncSetAttribute((const void*)mk_fwd, hipFuncAttributeMaxDynamicSharedMemorySize, LDS_BYTES) != hipSuccess) { fprintf(stderr, "kernel_launch: hipFuncSetAttribute failed\n"); grid = -1; return; }
        if (hipOccupancyMaxActiveBlocksPerMultiprocessor(&per_cu, (const void*)mk_fwd, NWAVES * 64, LDS_BYTES) != hipSuccess || per_cu < 1) { fprintf(stderr, "kernel_launch: occupancy query says %d\n", per_cu); per_cu = 1; }
        (void)hipGetLastError();
        grid = cus * (per_cu > 1 ? 1 : per_cu);
        fprintf(stderr, "kernel_launch: grid %d (cus %d per_cu %d)\n", grid, cus, per_cu);
    }
    if (grid < 0) return;
    Args a{};
    for (int i = 0; i < 22; ++i) a.in[i] = (const float*)d_in[i];
    a.out = (float*)d_out; a.ws = (unsigned char*)d_ws;
#if MK_MULTI
    for (int p = 0; p < N_PHASES; ++p) {
        a.ph_lo = p; a.ph_hi = p + 1;
        void* kargs[] = {&a};
        hipError_t e = hipLaunchCooperativeKernel((const void*)mk_fwd, dim3(grid), dim3(NWAVES * 64), kargs, LDS_BYTES, stream);
        if (e != hipSuccess) { fprintf(stderr, "kernel_launch: launch %d failed: %s\n", p, hipGetErrorString(e)); break; }
    }
#else
    a.ph_lo = 0; a.ph_hi = N_PHASES;
    void* kargs[] = {&a};
    hipError_t e = hipLaunchCooperativeKernel((const void*)mk_fwd, dim3(grid), dim3(NWAVES * 64), kargs, LDS_BYTES, stream);
    if (e != hipSuccess) fprintf(stderr, "kernel_launch: cooperative launch failed: %s (grid %d)\n", hipGetErrorString(e), grid);
#endif
}
```

```cpp
#include <hip/hip_runtime.h>
#include <hip/hip_cooperative_groups.h>
#include <cstdio>
#include <cstdint>
namespace cg = cooperative_groups;

#ifndef MK_MULTI
#define MK_MULTI 0
#endif

namespace pg8 {
#define PG8_LAS __attribute__((address_space(3)))
typedef unsigned short bf16_t;
typedef short bf16x8 __attribute__((ext_vector_type(8)));
typedef float f32x4 __attribute__((ext_vector_type(4)));
typedef unsigned u32x4 __attribute__((ext_vector_type(4)));
constexpr int BM = 256, BK = 64, HALF = 128, HTB = HALF * BK * 2  , STAGE_BYTES = 8 * HTB, NXCD = 8, WGM = 8;

__host__ __device__ __forceinline__ int lds_byte(int r, int c) { const int st = (r >> 4) * 2 + (c >> 5), rr = r & 15, cc = c & 31, ob = rr * 64 + cc * 2; return st * 1024 + (ob ^ (((ob >> 9) & 1) << 5)); }
__host__ __device__ __forceinline__ void stage_rc(int b, int& R, int& C) { const int st = b / 1024, sb = b % 1024, swz = sb ^ (((sb >> 9) & 1) << 5); R = (st >> 1) * 16 + swz / 64; C = (st & 1) * 32 + (swz % 64) / 2; }
__host__ __device__ __forceinline__ int perm32(int rho) { const int n = rho >> 4, i = rho & 15; return 8 * (i >> 2) + 4 * n + (i & 3); }

struct Unit { int pm, pn; };
struct Gemm { const bf16_t* A; const bf16_t* Bt; int M, N, K; };

struct StaticOrder {
    int nM, nN, nwg, G, c;
    __host__ __device__ void init(int M, int N, int G_, int c_) { nM = M / BM; nN = N / BM; nwg = nM * nN; G = G_; c = c_; }
    __host__ __device__ bool next(int i, Unit& u) const {
        const long L = (long)i * G + c; if (L >= nwg) return false;
        int wgid = (int)L; { const int q = nwg / NXCD, r = nwg % NXCD, xcd = wgid % NXCD, off = wgid / NXCD; wgid = (xcd < r ? xcd * (q + 1) : r * (q + 1) + (xcd - r) * q) + off; }
        const int nig = WGM * nN, gid = wgid / nig, fm = gid * WGM, gsz = (nM - fm) < WGM ? (nM - fm) : WGM;
        u.pm = fm + ((wgid % nig) % gsz); u.pn = (wgid % nig) / gsz; return true;
    }
    __device__ __forceinline__ void a_ready(const Unit&) const {}
    __device__ __forceinline__ void done(const Unit&) const {}
};

template <class Epi, class Sched, bool ALIGN_EPI = false, bool SP2 = false>
__device__ __forceinline__ void gemm_phase(PG8_LAS unsigned char* lds, const Gemm g, const Sched& S, const Epi& E) {
    int tid_ = threadIdx.x; asm volatile("" : "+v"(tid_));
    const int tid = tid_, wid = __builtin_amdgcn_readfirstlane(tid >> 6), lane = tid & 63, wr = wid >> 2, wc = wid & 3, fr = lane & 15, fq = lane >> 4;
    const int K = g.K, nt = K / BK;
    unsigned voffA[2], voffB[2];
#pragma unroll
    for (int i = 0; i < 2; ++i) { int R, C; stage_rc(tid * 16 + i * 8192, R, C); const int Rb = Epi::PERM ? ((R & ~31) + perm32(R & 31)) : R;
        voffA[i] = (unsigned)(R * K + C) * 2u; voffB[i] = (unsigned)(Rb * K + C) * 2u; }
    const size_t kstep = (size_t)(BK * 2);
    const size_t hstep = (size_t)HALF * K * 2;
    const size_t tstep = 2 * hstep;
    const unsigned ldsw = (unsigned)wid * 1024u;
    const int aoff = lds_byte(wr * 64 + fr, fq * 8), boff = lds_byte(wc * 32 + fr, fq * 8);
#define PG8_SA(b, h) (((b) * 2 + (h)) * HTB)
#define PG8_SB(b, h) ((4 + (b) * 2 + (h)) * HTB)
#define PG8_STAGE(bufoff, gbase, voff) do { _Pragma("unroll") for (int _i = 0; _i < 2; ++_i) \
        __builtin_amdgcn_global_load_lds((const unsigned*)((const char*)(gbase) + (voff)[_i]), (PG8_LAS unsigned*)(lds + (bufoff) + ldsw + _i * 8192), 16, 0, 0); } while (0)
#define PG8_LDA(dst, b, h) do { _Pragma("unroll") for (int m = 0; m < 4; ++m) _Pragma("unroll") for (int k = 0; k < 2; ++k) dst[m][k] = *(const PG8_LAS bf16x8*)(lds + PG8_SA(b, h) + aoff + m * 2048 + k * 1024); } while (0)
#define PG8_LDB(dst, b, h) do { _Pragma("unroll") for (int n = 0; n < 2; ++n) _Pragma("unroll") for (int k = 0; k < 2; ++k) dst[n][k] = *(const PG8_LAS bf16x8*)(lds + PG8_SB(b, h) + boff + n * 2048 + k * 1024); } while (0)
#define PG8_MMA(ai, bj, At, Bt) do { __builtin_amdgcn_s_setprio(1); _Pragma("unroll") for (int m = 0; m < 4; ++m) _Pragma("unroll") for (int n = 0; n < 2; ++n) _Pragma("unroll") for (int k = 0; k < 2; ++k) \
        acc[ai][bj][m][n] = __builtin_amdgcn_mfma_f32_16x16x32_bf16(Bt[n][k], At[m][k], acc[ai][bj][m][n], 0, 0, 0); __builtin_amdgcn_s_setprio(0); } while (0)
#define PG8_WAIT_V(n) asm volatile("s_waitcnt vmcnt(" #n ")" ::: "memory")
#define PG8_WAIT_L(n) asm volatile("s_waitcnt lgkmcnt(" #n ")" ::: "memory")
#define PG8_BAR __builtin_amdgcn_s_barrier()
#define PG8_SCHED __builtin_amdgcn_sched_barrier(0)
    Unit cur, nxt; int ui = 0;
    if (!S.next(0, cur)) return;
    f32x4 acc[2][2][4][2];
#pragma unroll
    for (int a = 0; a < 2; ++a)
#pragma unroll
        for (int b = 0; b < 2; ++b)
#pragma unroll
            for (int m = 0; m < 4; ++m)
#pragma unroll
                for (int n = 0; n < 2; ++n) acc[a][b][m][n] = (f32x4){0.f, 0.f, 0.f, 0.f};
    bf16x8 At[4][2], B0[2][2], B1[2][2];
    const char* cA = (const char*)g.A + (size_t)cur.pm * tstep; const char* cB = (const char*)g.Bt + (size_t)cur.pn * tstep;
    S.a_ready(cur);
    if constexpr (SP2) {
        PG8_STAGE(PG8_SB(0, 0), cB, voffB); PG8_STAGE(PG8_SB(0, 1), cB + hstep, voffB); PG8_STAGE(PG8_SA(0, 0), cA, voffA); PG8_STAGE(PG8_SA(0, 1), cA + hstep, voffA);
        if (wr == 1) PG8_BAR;
        PG8_WAIT_V(2); PG8_BAR;
        PG8_STAGE(PG8_SB(1, 0), cB + kstep, voffB); PG8_STAGE(PG8_SA(1, 0), cA + kstep, voffA); PG8_STAGE(PG8_SB(1, 1), cB + hstep + kstep, voffB);
        PG8_WAIT_V(6); PG8_BAR;
    } else {
        PG8_STAGE(PG8_SB(0, 0), cB, voffB); PG8_STAGE(PG8_SA(0, 0), cA, voffA); PG8_STAGE(PG8_SB(0, 1), cB + hstep, voffB); PG8_STAGE(PG8_SA(0, 1), cA + hstep, voffA);
        if (wr == 1) PG8_BAR;
        PG8_WAIT_V(4); PG8_BAR;
        PG8_STAGE(PG8_SB(1, 0), cB + kstep, voffB); PG8_STAGE(PG8_SA(1, 0), cA + kstep, voffA); PG8_STAGE(PG8_SB(1, 1), cB + hstep + kstep, voffB);
        PG8_WAIT_V(6); PG8_BAR;
    }
    for (;;) {
        const bool has_next = S.next(ui + 1, nxt);
        const char* nA = has_next ? (const char*)g.A + (size_t)nxt.pm * tstep : cA; const char* nB = has_next ? (const char*)g.Bt + (size_t)nxt.pn * tstep : cB;
        for (int t = 0; t < nt; t += 2) {
            const bool last = (t == nt - 2);
            const char* a1 = cA + (size_t)(t + 1) * kstep;
            const char* a2 = last ? nA : cA + (size_t)(t + 2) * kstep; const char* b2 = last ? nB : cB + (size_t)(t + 2) * kstep;
            const char* a3 = a2 + kstep; const char* b3 = b2 + kstep;
            if (last && has_next) S.a_ready(nxt);
            if constexpr (SP2) {
            PG8_LDB(B0, 0, 0); PG8_LDB(B1, 0, 1); PG8_SCHED; PG8_LDA(At, 0, 0); PG8_STAGE(PG8_SA(1, 1), a1 + hstep, voffA);
            PG8_WAIT_V(8); PG8_WAIT_L(0); PG8_BAR; PG8_MMA(0, 0, At, B0); PG8_MMA(0, 1, At, B1); PG8_BAR; PG8_SCHED;
            PG8_LDA(At, 0, 1); PG8_STAGE(PG8_SB(0, 0), b2, voffB); PG8_STAGE(PG8_SB(0, 1), b2 + hstep, voffB); PG8_STAGE(PG8_SA(0, 0), a2, voffA);
            PG8_WAIT_V(8); PG8_WAIT_L(0); PG8_BAR; PG8_MMA(1, 0, At, B0); PG8_MMA(1, 1, At, B1); PG8_BAR; PG8_SCHED;
            PG8_LDB(B0, 1, 0); PG8_LDB(B1, 1, 1); PG8_SCHED; PG8_LDA(At, 1, 0); PG8_STAGE(PG8_SA(0, 1), a2 + hstep, voffA);
            PG8_WAIT_V(8); PG8_WAIT_L(0); PG8_BAR; PG8_MMA(0, 0, At, B0); PG8_MMA(0, 1, At, B1); PG8_BAR; PG8_SCHED;
            PG8_LDA(At, 1, 1); PG8_STAGE(PG8_SB(1, 0), b3, voffB); PG8_STAGE(PG8_SB(1, 1), b3 + hstep, voffB); PG8_STAGE(PG8_SA(1, 0), a3, voffA);
            PG8_WAIT_V(8); PG8_WAIT_L(0); PG8_BAR; PG8_MMA(1, 0, At, B0); PG8_MMA(1, 1, At, B1); PG8_BAR; PG8_SCHED;
            } else {
            PG8_LDB(B0, 0, 0); PG8_SCHED; PG8_LDA(At, 0, 0); PG8_STAGE(PG8_SA(1, 1), a1 + hstep, voffA);
            PG8_WAIT_L(8); PG8_BAR; PG8_WAIT_L(0); PG8_MMA(0, 0, At, B0); PG8_BAR; PG8_SCHED;
            PG8_LDB(B1, 0, 1); PG8_STAGE(PG8_SB(0, 0), b2, voffB);
            PG8_BAR; PG8_WAIT_L(0); PG8_MMA(0, 1, At, B1); PG8_BAR;
            PG8_LDA(At, 0, 1); PG8_STAGE(PG8_SA(0, 0), a2, voffA);
            PG8_BAR; PG8_WAIT_L(0); PG8_MMA(1, 0, At, B0); PG8_BAR; PG8_SCHED;
            PG8_STAGE(PG8_SB(0, 1), b2 + hstep, voffB);
            PG8_WAIT_V(6); PG8_BAR; PG8_MMA(1, 1, At, B1); PG8_BAR;
            PG8_LDB(B0, 1, 0); PG8_SCHED; PG8_LDA(At, 1, 0); PG8_STAGE(PG8_SA(0, 1), a2 + hstep, voffA);
            PG8_WAIT_L(8); PG8_BAR; PG8_WAIT_L(0); PG8_MMA(0, 0, At, B0); PG8_BAR; PG8_SCHED;
            PG8_LDB(B1, 1, 1); PG8_STAGE(PG8_SB(1, 0), b3, voffB);
            PG8_BAR; PG8_WAIT_L(0); PG8_MMA(0, 1, At, B1); PG8_BAR;
            PG8_LDA(At, 1, 1); PG8_STAGE(PG8_SA(1, 0), a3, voffA);
            PG8_BAR; PG8_WAIT_L(0); PG8_MMA(1, 0, At, B0); PG8_BAR; PG8_SCHED;
            PG8_STAGE(PG8_SB(1, 1), b3 + hstep, voffB);
            PG8_WAIT_V(6); PG8_BAR; PG8_MMA(1, 1, At, B1); PG8_BAR;
            }
        }
        if constexpr (ALIGN_EPI) { if (wr == 0) PG8_BAR; }
        if constexpr (!Epi::AFTER_DRAIN) { E(acc, cur, wr, wc, fr, fq); S.done(cur); }
        if (!has_next) break;
#pragma unroll
        for (int a = 0; a < 2; ++a)
#pragma unroll
            for (int b = 0; b < 2; ++b)
#pragma unroll
                for (int m = 0; m < 4; ++m)
#pragma unroll
                    for (int n = 0; n < 2; ++n) acc[a][b][m][n] = (f32x4){0.f, 0.f, 0.f, 0.f};
        cur = nxt; cA = nA; cB = nB; ++ui;
        if constexpr (ALIGN_EPI) { if (wr == 1) PG8_BAR; }
    }
    PG8_WAIT_V(0);
    if constexpr (!ALIGN_EPI) { if (wr == 0) PG8_BAR; }
    PG8_BAR;
    if constexpr (Epi::AFTER_DRAIN) { E.fused(acc, cur, wr, wc, fr, fq, lds, wid, lane); S.done(cur); }
#undef PG8_SA
#undef PG8_SB
#undef PG8_STAGE
#undef PG8_LDA
#undef PG8_LDB
#undef PG8_MMA
#undef PG8_WAIT_V
#undef PG8_WAIT_L
#undef PG8_BAR
#undef PG8_SCHED
}
}

constexpr int NWAVES = 8;
constexpr int D = 1024, FF = 2816, NIN = 3584, MP = 16384, MS = 256, M = MP + MS, SEQ = 4096;
constexpr int SEG_Q = 0, SEG_K = 512, SEG_V = 1024, SEG_BQ = 1536, SEG_BF = 2048, SEG_BI = 2560, SEG_BG = 3072;
constexpr float EPS = 1e-6f;
constexpr size_t OFF_Y = 0, OFF_KP = 17039360, OFF_VP = 25427968, OFF_SP = 33816576, OFF_KS = 34340864, OFF_VS = 34603008, OFF_SS = 34865152;
constexpr size_t MiB = 1u << 20;
constexpr size_t WS_LB = 0;
constexpr size_t WS_W = 1 * MiB;
constexpr size_t W_G1 = 0, W_D1 = W_G1 + (size_t)2 * FF * D, W_IN = W_D1 + (size_t)D * FF, W_OUT = W_IN + (size_t)NIN * D,
                 W_G2 = W_OUT + (size_t)D * D, W_D2 = W_G2 + (size_t)2 * FF * D, W_LAYER = W_D2 + (size_t)D * FF;
constexpr size_t WS_XN = WS_W + 2 * W_LAYER * 2;
constexpr size_t WS_O = WS_XN + (size_t)M * D * 2;
constexpr size_t WS_HID = WS_O + (size_t)M * D * 2;
constexpr size_t WS_Y = WS_HID + (size_t)M * FF * 2;
constexpr size_t WS_H = WS_Y + (size_t)M * D * 4;
constexpr size_t WS_Z = WS_H + (size_t)M * D * 4;
constexpr size_t WS_OA = WS_Z + (size_t)M * NIN * 4;
constexpr size_t WS_OH = WS_OA + (size_t)M * 512 * 4;
constexpr size_t WS_QB = WS_OH + (size_t)M * 512 * 4;
constexpr size_t WS_KB = WS_QB + (size_t)MP * 512 * 2;
constexpr size_t WS_VB = WS_KB + (size_t)MP * 512 * 2;
constexpr size_t WS_OP = WS_VB + (size_t)MP * 512 * 2;
constexpr size_t WS_LSE = WS_OP + (size_t)3 * MP * 512 * 2;
constexpr size_t WS_END = WS_LSE + (size_t)3 * MP * 8 * 4;
constexpr int LDS_BYTES = 147456;

#define GAS __attribute__((address_space(1)))
#define LAS __attribute__((address_space(3)))
typedef unsigned short bf16;
typedef unsigned v4u __attribute__((ext_vector_type(4)));
typedef float f32x4 __attribute__((ext_vector_type(4)));
#define LDS_WAIT() asm volatile("s_waitcnt lgkmcnt(0)" ::: "memory")

__device__ __forceinline__ unsigned f2bf(float f) { unsigned u = __builtin_bit_cast(unsigned, f); return (u + 0x7fffu + ((u >> 16) & 1u)) >> 16; }
__device__ __forceinline__ unsigned pk2(float lo, float hi) { return f2bf(lo) | (f2bf(hi) << 16); }
__device__ __forceinline__ float silu_f(float x) { return x * __frcp_rn(1.f + __expf(-x)); }
__device__ __forceinline__ float sigmoid_f(float x) { return __frcp_rn(1.f + __expf(-x)); }
__device__ __forceinline__ float wave_sum(float v) {
#pragma unroll
    for (int o = 1; o < 64; o <<= 1) v += __shfl_xor(v, o);
    return v;
}
__device__ __forceinline__ float wave_max(float v) {
#pragma unroll
    for (int o = 1; o < 64; o <<= 1) v = fmaxf(v, __shfl_xor(v, o));
    return v;
}

struct EpiSwiglu {
    static constexpr bool PERM = true, AFTER_DRAIN = false;
    bf16* H;
    __device__ __forceinline__ void operator()(const pg8::f32x4 (&acc)[2][2][4][2], const pg8::Unit& u, int wr, int wc, int fr, int fq) const {
        const int row0 = u.pm * 256 + wr * 64 + fr, col0 = u.pn * 128 + wc * 32 + 8 * fq;
#pragma unroll
        for (int ai = 0; ai < 2; ++ai)
#pragma unroll
            for (int m = 0; m < 4; ++m) {
                bf16* rowp = H + (size_t)(row0 + ai * 128 + m * 16) * FF + col0;
                const pg8::f32x4 g0 = acc[ai][0][m][0], g1 = acc[ai][0][m][1], u0 = acc[ai][1][m][0], u1 = acc[ai][1][m][1];
                v4u w;
                w.x = pk2(silu_f(g0[0]) * u0[0], silu_f(g0[1]) * u0[1]); w.y = pk2(silu_f(g0[2]) * u0[2], silu_f(g0[3]) * u0[3]);
                w.z = pk2(silu_f(g1[0]) * u1[0], silu_f(g1[1]) * u1[1]); w.w = pk2(silu_f(g1[2]) * u1[2], silu_f(g1[3]) * u1[3]);
                *(v4u*)rowp = w;
            }
    }
};
struct EpiF32 {
    static constexpr bool PERM = true, AFTER_DRAIN = false;
    float* Y; int ldc;
    __device__ __forceinline__ void operator()(const pg8::f32x4 (&acc)[2][2][4][2], const pg8::Unit& u, int wr, int wc, int fr, int fq) const {
        const int row0 = u.pm * 256 + wr * 64 + fr, col0 = u.pn * 256 + wc * 32 + 8 * fq;
#pragma unroll
        for (int ai = 0; ai < 2; ++ai)
#pragma unroll
            for (int m = 0; m < 4; ++m) {
                float* rowp = Y + (size_t)(row0 + ai * 128 + m * 16) * ldc + col0;
#pragma unroll
                for (int bj = 0; bj < 2; ++bj)
#pragma unroll
                    for (int n = 0; n < 2; ++n) *(f32x4*)(rowp + bj * 128 + 4 * n) = acc[ai][bj][m][n];
            }
    }
};
struct EpiMix {
    static constexpr bool PERM = true, AFTER_DRAIN = false;
    float* Z; const float* lb; float* out; int l; bf16* QKV;
    __device__ __forceinline__ void operator()(const pg8::f32x4 (&acc)[2][2][4][2], const pg8::Unit& u, int wr, int wc, int fr, int fq) const {
        const int seg = u.pn >> 1;
        const int row0 = u.pm * 256 + wr * 64 + fr, cs0 = (u.pn & 1) * 256 + wc * 32 + 8 * fq;
        f32x4 lbv[2][2];
#pragma unroll
        for (int bj = 0; bj < 2; ++bj)
#pragma unroll
            for (int n = 0; n < 2; ++n) lbv[bj][n] = (seg == 4) ? *(const f32x4*)(lb + cs0 + bj * 128 + 4 * n) : (f32x4){0.f, 0.f, 0.f, 0.f};
#pragma unroll
        for (int ai = 0; ai < 2; ++ai)
#pragma unroll
            for (int m = 0; m < 4; ++m) {
                const int row = row0 + ai * 128 + m * 16;
                float* zrow = Z + (size_t)row * NIN + seg * 512 + cs0;
                float* orow = nullptr;
                f32x4 vv[2][2];
                if (seg == 1 || seg == 2) {
                    if (row < MP) { const int b = row >> 12, t = row & 4095;
                        if (t >= 2048) orow = out + (seg == 1 ? OFF_KP : OFF_VP) + ((size_t)(l * 4 + b) * 2048 + (t - 2048)) * 512 + cs0; }
                    else orow = out + (seg == 1 ? OFF_KS : OFF_VS) + ((size_t)l * 256 + (row - MP)) * 512 + cs0;
                }
#pragma unroll
                for (int bj = 0; bj < 2; ++bj)
#pragma unroll
                    for (int n = 0; n < 2; ++n) {
                        f32x4 v = acc[ai][bj][m][n];
                        if (seg == 0) v = v * 0.125f;
                        else if (seg == 3 || seg == 6) { v[0] = silu_f(v[0]); v[1] = silu_f(v[1]); v[2] = silu_f(v[2]); v[3] = silu_f(v[3]); }
                        else if (seg == 4) {
                            const f32x4 b4 = lbv[bj][n];
#pragma unroll
                            for (int i = 0; i < 4; ++i) v[i] = b4[i] + (1.f - b4[i]) * sigmoid_f(v[i]);
                        }
                        if (!(seg < 3 && row < MP)) *(f32x4*)(zrow + bj * 128 + 4 * n) = v;
                        if (orow) *(f32x4*)(orow + bj * 128 + 4 * n) = v;
                        vv[bj][n] = v;
                    }
                if (seg < 3 && row < MP) {
                    bf16* qrow = QKV + (size_t)seg * MP * 512 + (size_t)row * 512 + cs0;
#pragma unroll
                    for (int bj = 0; bj < 2; ++bj) { v4u w; w.x = pk2(vv[bj][0][0], vv[bj][0][1]); w.y = pk2(vv[bj][0][2], vv[bj][0][3]); w.z = pk2(vv[bj][1][0], vv[bj][1][1]); w.w = pk2(vv[bj][1][2], vv[bj][1][3]);
                        *(v4u*)(qrow + bj * 128) = w; }
                }
            }
    }
};

__device__ __forceinline__ void p0_transpose_item(const float* W, int K, int N, bf16* WT, int mode, LAS float* scr, int item, int lane) {
    const int nblk = N / 32, kb = item / nblk, nb = item % nblk, k0 = 64 * kb, n0 = 32 * nb;
    const int r0 = (mode == 0) ? n0 : ((n0 >> 7) * 256 + (mode - 1) * 128 + (n0 & 127));
#pragma unroll 8
    for (int i = 0; i < 32; ++i) { const int kk = 2 * i + (lane >> 5); scr[kk * 33 + (lane & 31)] = W[(size_t)(k0 + kk) * N + n0 + (lane & 31)]; }
    LDS_WAIT(); asm volatile("" ::: "memory");
    const int c = lane & 7;
#pragma unroll
    for (int j = 0; j < 4; ++j) { const int n = (lane >> 3) + 8 * j; const LAS float* s = scr + (8 * c) * 33 + n;
        v4u o; o.x = pk2(s[0 * 33], s[1 * 33]); o.y = pk2(s[2 * 33], s[3 * 33]); o.z = pk2(s[4 * 33], s[5 * 33]); o.w = pk2(s[6 * 33], s[7 * 33]);
        *(v4u*)(WT + (size_t)(r0 + n) * K + k0 + 8 * c) = o; }
    LDS_WAIT(); asm volatile("" ::: "memory");
}

template <bool HAS_Y>
__device__ __forceinline__ void row_phase(const float* res_p, const float* res_s  , const float* Y, const float* post_g, float coef,
                                          float* hout, const float* pre_g, bf16* xn, int gw, int NGW, int lane) {
    for (int row = gw; row < M; row += NGW) {
        const float* rp = (res_s && row >= MP) ? res_s + (size_t)(row - MP) * D : res_p + (size_t)row * D;
        f32x4 v[4];
#pragma unroll
        for (int j = 0; j < 4; ++j) v[j] = *((const f32x4*)rp + lane + 64 * j);
        if (HAS_Y) {
            f32x4 y[4]; float s = 0.f;
#pragma unroll
            for (int j = 0; j < 4; ++j) { y[j] = *((const f32x4*)(Y + (size_t)row * D) + lane + 64 * j); s += (y[j][0] * y[j][0] + y[j][1] * y[j][1]) + (y[j][2] * y[j][2] + y[j][3] * y[j][3]); }
            const float rstd = coef * rsqrtf(wave_sum(s) * (1.f / D) + EPS);
#pragma unroll
            for (int j = 0; j < 4; ++j) { const f32x4 g = *((const f32x4*)post_g + lane + 64 * j); v[j] = v[j] + y[j] * g * rstd; }
        }
        if (hout) {
#pragma unroll
            for (int j = 0; j < 4; ++j) *((f32x4*)(hout + (size_t)row * D) + lane + 64 * j) = v[j];
        }
        if (pre_g) {
            float s = 0.f;
#pragma unroll
            for (int j = 0; j < 4; ++j) s += (v[j][0] * v[j][0] + v[j][1] * v[j][1]) + (v[j][2] * v[j][2] + v[j][3] * v[j][3]);
            const float rstd = rsqrtf(wave_sum(s) * (1.f / D) + EPS);
            unsigned long long* o8 = (unsigned long long*)(xn + (size_t)row * D) + lane;
#pragma unroll
            for (int j = 0; j < 4; ++j) { const f32x4 g = *((const f32x4*)pre_g + lane + 64 * j); const f32x4 w = v[j] * g * rstd;
                o8[64 * j] = (unsigned long long)pk2(w[0], w[1]) | ((unsigned long long)pk2(w[2], w[3]) << 32); }
        }
    }
}

__device__ __forceinline__ float bflo(unsigned u) { return __builtin_bit_cast(float, u << 16); }
__device__ __forceinline__ float bfhi(unsigned u) { return __builtin_bit_cast(float, u & 0xffff0000u); }
__device__ __forceinline__ void r3_phase(const float* OA, const bf16* OP, const float* LSE, const float* OH, const float* Z, const float* attn_g, const float* hgrn_g, bf16* O, int gw, int NGW, int lane) {
    for (int row = gw; row < M; row += NGW) {
        f32x4 a0, a1;
        if (row < MP) {
            const int hd = lane >> 3;
            const float l0 = LSE[((size_t)0 * MP + row) * 8 + hd], l1 = LSE[((size_t)1 * MP + row) * 8 + hd], l2 = LSE[((size_t)2 * MP + row) * 8 + hd];
            const float mx = fmaxf(l0, fmaxf(l1, l2));
            float w0 = __expf(l0 - mx), w1 = __expf(l1 - mx), w2 = __expf(l2 - mx);
            const float iw = 1.f / (w0 + w1 + w2); w0 *= iw; w1 *= iw; w2 *= iw;
            const v4u p0 = *((const v4u*)(OP + ((size_t)0 * MP + row) * 512) + lane), p1 = *((const v4u*)(OP + ((size_t)1 * MP + row) * 512) + lane), p2 = *((const v4u*)(OP + ((size_t)2 * MP + row) * 512) + lane);
            a0[0] = w0 * bflo(p0.x) + w1 * bflo(p1.x) + w2 * bflo(p2.x); a0[1] = w0 * bfhi(p0.x) + w1 * bfhi(p1.x) + w2 * bfhi(p2.x);
            a0[2] = w0 * bflo(p0.y) + w1 * bflo(p1.y) + w2 * bflo(p2.y); a0[3] = w0 * bfhi(p0.y) + w1 * bfhi(p1.y) + w2 * bfhi(p2.y);
            a1[0] = w0 * bflo(p0.z) + w1 * bflo(p1.z) + w2 * bflo(p2.z); a1[1] = w0 * bfhi(p0.z) + w1 * bfhi(p1.z) + w2 * bfhi(p2.z);
            a1[2] = w0 * bflo(p0.w) + w1 * bflo(p1.w) + w2 * bflo(p2.w); a1[3] = w0 * bfhi(p0.w) + w1 * bfhi(p1.w) + w2 * bfhi(p2.w);
        } else {
            a0 = *((const f32x4*)(OA + (size_t)row * 512) + 2 * lane); a1 = *((const f32x4*)(OA + (size_t)row * 512) + 2 * lane + 1);
        }
        const f32x4 h0 = *((const f32x4*)(OH + (size_t)row * 512) + 2 * lane), h1 = *((const f32x4*)(OH + (size_t)row * 512) + 2 * lane + 1);
        const f32x4 g0 = *((const f32x4*)(Z + (size_t)row * NIN + SEG_BG) + 2 * lane), g1 = *((const f32x4*)(Z + (size_t)row * NIN + SEG_BG) + 2 * lane + 1);
        float sa = (a0[0] * a0[0] + a0[1] * a0[1]) + (a0[2] * a0[2] + a0[3] * a0[3]) + (a1[0] * a1[0] + a1[1] * a1[1]) + (a1[2] * a1[2] + a1[3] * a1[3]);
        float sh = (h0[0] * h0[0] + h0[1] * h0[1]) + (h0[2] * h0[2] + h0[3] * h0[3]) + (h1[0] * h1[0] + h1[1] * h1[1]) + (h1[2] * h1[2] + h1[3] * h1[3]);
        sa = wave_sum(sa);
#pragma unroll
        for (int o = 1; o < 16; o <<= 1) sh += __shfl_xor(sh, o);
        const float ra = rsqrtf(sa * (1.f / 512.f) + EPS), rh = rsqrtf(sh * (1.f / 128.f) + EPS);
        const f32x4 ag0 = *((const f32x4*)attn_g + 2 * lane), ag1 = *((const f32x4*)attn_g + 2 * lane + 1);
        const f32x4 hg0 = *((const f32x4*)hgrn_g + 2 * (lane & 15)), hg1 = *((const f32x4*)hgrn_g + 2 * (lane & 15) + 1);
        const f32x4 oa0 = a0 * ag0 * ra, oa1 = a1 * ag1 * ra, ob0 = h0 * hg0 * rh * g0, ob1 = h1 * hg1 * rh * g1;
        v4u wa, wb;
        wa.x = pk2(oa0[0], oa0[1]); wa.y = pk2(oa0[2], oa0[3]); wa.z = pk2(oa1[0], oa1[1]); wa.w = pk2(oa1[2], oa1[3]);
        wb.x = pk2(ob0[0], ob0[1]); wb.y = pk2(ob0[2], ob0[3]); wb.z = pk2(ob1[0], ob1[1]); wb.w = pk2(ob1[2], ob1[3]);
        *((v4u*)(O + (size_t)row * D) + lane) = wa;
        *((v4u*)(O + (size_t)row * D + 512) + lane) = wb;
    }
}

typedef float f32x2 __attribute__((ext_vector_type(2)));
struct HgIn { f32x4 f, q; float v; };
__device__ __forceinline__ void hg_load(HgIn (&d)[4], const float* Z, int rowbase, int t0, int T, int h, int kq, int vcol) {
#pragma unroll
    for (int i = 0; i < 4; ++i) {
        int t = t0 + i; t = t < T ? t : T - 1;
        const float* zr = Z + (size_t)(rowbase + t) * NIN + h * 128;
        d[i].f = *(const f32x4*)(zr + SEG_BF + kq * 4); d[i].q = *(const f32x4*)(zr + SEG_BQ + kq * 4);
        d[i].v = zr[SEG_BI + vcol];
    }
}
__device__ __forceinline__ void hg_step4(const HgIn (&d)[4], f32x2& Sa, f32x2& Sb, LAS float* scr, int slot0, int lane) {
#pragma unroll
    for (int i = 0; i < 4; ++i) {
        const f32x2 vv = {d[i].v, d[i].v};
        const f32x2 fa = {d[i].f[0], d[i].f[1]}, fb = {d[i].f[2], d[i].f[3]}, qa = {d[i].q[0], d[i].q[1]}, qb = {d[i].q[2], d[i].q[3]};
        Sa = fa * (Sa - vv) + vv; Sb = fb * (Sb - vv) + vv;
        const f32x2 pr = qa * Sa + qb * Sb;
        scr[(slot0 + i) * 64 + lane] = pr[0] + pr[1];
    }
}
template <int BS>
__device__ __forceinline__ void hgrn_task(const float* Z, float* OH, const float* s0, float* sout, int rowbase, int T, int h, int vg, LAS float* scr, int lane) {
    const int kq = lane & 31, g = lane >> 5, vcol = vg * 2 + g;
    f32x2 Sa, Sb;
    Sa[0] = s0 ? s0[(size_t)(kq * 4 + 0) * 128 + vcol] : 0.f; Sa[1] = s0 ? s0[(size_t)(kq * 4 + 1) * 128 + vcol] : 0.f;
    Sb[0] = s0 ? s0[(size_t)(kq * 4 + 2) * 128 + vcol] : 0.f; Sb[1] = s0 ? s0[(size_t)(kq * 4 + 3) * 128 + vcol] : 0.f;
    HgIn A[4], B[4];
    hg_load(A, Z, rowbase, 0, T, h, kq, vcol);
    for (int t0 = 0; t0 < T; t0 += BS) {
#pragma unroll 1
        for (int u = 0; u < BS; u += 8) {
            hg_load(B, Z, rowbase, t0 + u + 4, T, h, kq, vcol);
            hg_step4(A, Sa, Sb, scr, u, lane);
            hg_load(A, Z, rowbase, t0 + u + 8, T, h, kq, vcol);
            hg_step4(B, Sa, Sb, scr, u + 4, lane);
        }
        __builtin_amdgcn_wave_barrier(); LDS_WAIT();
        if (kq < BS) {
            float sum = 0.f;
#pragma unroll 8
            for (int i = 0; i < 32; ++i) sum += scr[kq * 64 + g * 32 + ((i + kq) & 31)];
            OH[(size_t)(rowbase + t0 + kq) * 512 + h * 128 + vcol] = sum;
        }
        __builtin_amdgcn_wave_barrier(); LDS_WAIT();
    }
    sout[(size_t)(kq * 4 + 0) * 128 + vcol] = Sa[0]; sout[(size_t)(kq * 4 + 1) * 128 + vcol] = Sa[1];
    sout[(size_t)(kq * 4 + 2) * 128 + vcol] = Sb[0]; sout[(size_t)(kq * 4 + 3) * 128 + vcol] = Sb[1];
}

typedef short bf16x8 __attribute__((ext_vector_type(8)));
typedef float f32x16 __attribute__((ext_vector_type(16)));
typedef float f32x2_t __attribute__((ext_vector_type(2))); typedef __bf16 bf16x2_t __attribute__((ext_vector_type(2)));
__device__ __forceinline__ unsigned cvtpk(float lo, float hi) { f32x2_t v = {lo, hi}; bf16x2_t b = __builtin_convertvector(v, bf16x2_t); return __builtin_bit_cast(unsigned, b); }
#define MFMA32(a, b, c) __builtin_amdgcn_mfma_f32_32x32x16_bf16((a), (b), (c), 0, 0, 0)
__device__ __forceinline__ void attn_unit(int u, const bf16* QB, const bf16* KB, const bf16* VB, bf16* OP, float* LSE, LAS unsigned char* vimg, int lane) {
    const int h = u & 7; int t = u >> 3; const int tile = t & 127; t >>= 7; const int p = t % 3, b = t / 3;
    const int sh = 2 * p, r = tile >> (7 - sh), qt = tile & ((128 >> sh) - 1);
    const int c = lane & 31, hi = lane >> 5;
    const int qrow = b * SEQ + ((32 * qt + c) << sh) + r;
    bf16x8 qf[4];
#pragma unroll
    for (int ks = 0; ks < 4; ++ks) qf[ks] = *(const bf16x8*)(QB + (size_t)qrow * 512 + h * 64 + ks * 16 + hi * 8);
    f32x16 o0, o1;
#pragma unroll
    for (int i = 0; i < 16; ++i) { o0[i] = 0.f; o1[i] = 0.f; }
    float m = -INFINITY, l = 0.f;
    const int pr = (c & 0x13) | ((c & 8) >> 1) | ((c & 4) << 1);
    const int kt0 = (qt >= 4) ? 0 : 4 - qt;
#pragma unroll 1
    for (int kt = kt0; kt < 5; ++kt) {
        const int kb = 32 * qt - 128 + 32 * kt;
        const int krow = b * SEQ + ((kb + pr) << sh) + r, vrow = b * SEQ + ((kb + c) << sh) + r;
        bf16x8 kf[4], vf[4];
#pragma unroll
        for (int ks = 0; ks < 4; ++ks) kf[ks] = *(const bf16x8*)(KB + (size_t)krow * 512 + h * 64 + ks * 16 + hi * 8);
#pragma unroll
        for (int ks = 0; ks < 4; ++ks) vf[ks] = *(const bf16x8*)(VB + (size_t)vrow * 512 + h * 64 + ks * 16 + hi * 8);
        f32x16 s;
#pragma unroll
        for (int i = 0; i < 16; ++i) s[i] = 0.f;
#pragma unroll
        for (int ks = 0; ks < 4; ++ks) s = MFMA32(kf[ks], qf[ks], s);
#pragma unroll
        for (int ks = 0; ks < 4; ++ks)
#pragma unroll
            for (int e = 0; e < 8; ++e) *(LAS short*)(vimg + (ks * 16 + hi * 8 + e) * 80 + c * 2) = vf[ks][e];
        if (kt == 0) {
#pragma unroll
            for (int i = 0; i < 16; ++i) { const int ko = 16 * (i >> 3) + 8 * hi + (i & 7); s[i] = (ko >= c) ? s[i] : -INFINITY; }
        } else if (kt == 4) {
#pragma unroll
            for (int i = 0; i < 16; ++i) { const int ko = 16 * (i >> 3) + 8 * hi + (i & 7); s[i] = (ko <= c) ? s[i] : -INFINITY; }
        }
        float tmax = s[0];
#pragma unroll
        for (int i = 1; i < 16; ++i) tmax = fmaxf(tmax, s[i]);
        tmax = fmaxf(tmax, __shfl_xor(tmax, 32));
        const float mn = fmaxf(m, tmax), alpha = __expf(m - mn);
        float ls = 0.f;
#pragma unroll
        for (int i = 0; i < 16; ++i) { s[i] = __expf(s[i] - mn); ls += s[i]; }
        ls += __shfl_xor(ls, 32);
        l = l * alpha + ls; m = mn;
#pragma unroll
        for (int i = 0; i < 16; ++i) { o0[i] *= alpha; o1[i] *= alpha; }
        bf16x8 pf[2];
#pragma unroll
        for (int s2 = 0; s2 < 2; ++s2) { v4u w; w.x = cvtpk(s[8 * s2 + 0], s[8 * s2 + 1]); w.y = cvtpk(s[8 * s2 + 2], s[8 * s2 + 3]); w.z = cvtpk(s[8 * s2 + 4], s[8 * s2 + 5]); w.w = cvtpk(s[8 * s2 + 6], s[8 * s2 + 7]);
            pf[s2] = __builtin_bit_cast(bf16x8, w); }
        __builtin_amdgcn_wave_barrier(); LDS_WAIT();
#pragma unroll
        for (int s2 = 0; s2 < 2; ++s2) {
            const bf16x8 a0 = *(const LAS bf16x8*)(vimg + c * 80 + (16 * s2 + 8 * hi) * 2);
            const bf16x8 a1 = *(const LAS bf16x8*)(vimg + (32 + c) * 80 + (16 * s2 + 8 * hi) * 2);
            o0 = MFMA32(a0, pf[s2], o0); o1 = MFMA32(a1, pf[s2], o1);
        }
        __builtin_amdgcn_wave_barrier(); LDS_WAIT();
    }
    const float inv = 1.f / l;
    bf16* orow = OP + ((size_t)p * MP + qrow) * 512 + h * 64;
#pragma unroll
    for (int gq = 0; gq < 4; ++gq) {
        unsigned long long w0 = (unsigned long long)cvtpk(o0[4 * gq] * inv, o0[4 * gq + 1] * inv) | ((unsigned long long)cvtpk(o0[4 * gq + 2] * inv, o0[4 * gq + 3] * inv) << 32);
        unsigned long long w1 = (unsigned long long)cvtpk(o1[4 * gq] * inv, o1[4 * gq + 1] * inv) | ((unsigned long long)cvtpk(o1[4 * gq + 2] * inv, o1[4 * gq + 3] * inv) << 32);
        *(unsigned long long*)(orow + 8 * gq + 4 * hi) = w0;
        *(unsigned long long*)(orow + 32 + 8 * gq + 4 * hi) = w1;
    }
    if (hi == 0) LSE[((size_t)p * MP + qrow) * 8 + h] = m + __logf(l);
}

__device__ __forceinline__ const float* kv_ptr(bool samp, int b, int idx, int h, int seg, const float* Z, const float* cache, int l) {
    if (!samp) return Z + (size_t)(b * SEQ + idx) * NIN + seg + h * 64;
    if (idx >= 2048) return Z + (size_t)(MP + b * 8 + (idx - 2048)) * NIN + seg + h * 64;
    return cache + ((((size_t)l * 32 + b) * 2048 + idx) * 8 + h) * 64;
}
__device__ __forceinline__ float dot64(const f32x4 (&q)[16], const float* kp) {
    float a0 = 0.f, a1 = 0.f, a2 = 0.f, a3 = 0.f;
#pragma unroll
    for (int i = 0; i < 16; ++i) { const f32x4 k = *((const f32x4*)kp + i); a0 = fmaf(q[i][0], k[0], a0); a1 = fmaf(q[i][1], k[1], a1); a2 = fmaf(q[i][2], k[2], a2); a3 = fmaf(q[i][3], k[3], a3); }
    return (a0 + a1) + (a2 + a3);
}
__device__ __forceinline__ v4u aent(float c, const float* p) { v4u e; e.x = __builtin_bit_cast(unsigned, c); e.y = 0u; const unsigned long long a = (unsigned long long)p; e.z = (unsigned)a; e.w = (unsigned)(a >> 32); return e; }
__device__ __forceinline__ void attn_item(int row, int h, int l, const float* Z, const float* ck, const float* cv, float* OA, LAS v4u* scr, int lane) {
    const bool samp = row >= MP;
    int b, pos;
    if (!samp) { b = row >> 12; pos = row & 4095; } else { const int r = row - MP; b = r >> 3; pos = 2048 + (r & 7); }
    float s0;
    {
        const float* qp = Z + (size_t)row * NIN + SEG_Q + h * 64;
        f32x4 q[16];
#pragma unroll
        for (int i = 0; i < 16; ++i) q[i] = *((const f32x4*)qp + i);
        s0 = dot64(q, kv_ptr(samp, b, pos, h, SEG_K, Z, ck, l));
#pragma unroll 1
        for (int ph = 0; ph < 6; ++ph) {
            const int d = 1 << (2 * (ph >> 1));
            const int j = 1 + (ph & 1) * 64 + lane; const int idx = pos - d * j; const bool valid = idx >= 0; const int ic = valid ? idx : pos;
            const float sdot = dot64(q, kv_ptr(samp, b, ic, h, SEG_K, Z, ck, l));
            scr[1 + ph * 64 + lane] = aent(valid ? sdot : -INFINITY, kv_ptr(samp, b, ic, h, SEG_V, Z, cv, l));
        }
    }
    const float* vself = kv_ptr(samp, b, pos, h, SEG_V, Z, cv, l);
    __builtin_amdgcn_wave_barrier(); LDS_WAIT();
    float sc[3][2], lse[3], e0[3], w[3];
#pragma unroll
    for (int p = 0; p < 3; ++p) {
        sc[p][0] = __builtin_bit_cast(float, scr[1 + p * 128 + lane].x); sc[p][1] = __builtin_bit_cast(float, scr[1 + p * 128 + 64 + lane].x);
        const float m = fmaxf(s0, wave_max(fmaxf(sc[p][0], sc[p][1])));
        sc[p][0] = __expf(sc[p][0] - m); sc[p][1] = __expf(sc[p][1] - m); e0[p] = __expf(s0 - m);
        const float lsum = e0[p] + wave_sum(sc[p][0] + sc[p][1]);
        lse[p] = m + __logf(lsum); w[p] = 1.f / lsum;
    }
    const float mx = fmaxf(lse[0], fmaxf(lse[1], lse[2]));
    const float x0 = __expf(lse[0] - mx), x1 = __expf(lse[1] - mx), x2 = __expf(lse[2] - mx);
    const float iw = 1.f / (x0 + x1 + x2);
    w[0] *= x0 * iw; w[1] *= x1 * iw; w[2] *= x2 * iw;
    const float cself = w[0] * e0[0] + w[1] * e0[1] + w[2] * e0[2];
#pragma unroll
    for (int p = 0; p < 3; ++p) { scr[1 + p * 128 + lane].x = __builtin_bit_cast(unsigned, w[p] * sc[p][0]); scr[1 + p * 128 + 64 + lane].x = __builtin_bit_cast(unsigned, w[p] * sc[p][1]); }
    if (lane < 4) scr[lane == 0 ? 0 : 384 + lane] = aent(lane == 0 ? cself : 0.f, vself);
    __builtin_amdgcn_wave_barrier(); LDS_WAIT();
    const int ks = lane >> 4, c4 = (lane & 15) * 4;
    f32x4 acc = {0.f, 0.f, 0.f, 0.f};
#pragma unroll 4
    for (int i = 0; i < 97; ++i) { const v4u e = scr[4 * i + ks]; const float* vp = (const float*)(((unsigned long long)e.w << 32) | e.z);
        const f32x4 v = *(const f32x4*)(vp + c4); acc = acc + v * __builtin_bit_cast(float, e.x); }
#pragma unroll
    for (int i = 0; i < 4; ++i) { acc[i] += __shfl_xor(acc[i], 16); acc[i] += __shfl_xor(acc[i], 32); }
    if (lane < 16) *(f32x4*)(OA + (size_t)row * 512 + h * 64 + c4) = acc;
    __builtin_amdgcn_wave_barrier(); LDS_WAIT();
}

struct Args { const float* in[22]; float* out; unsigned char* ws; int ph_lo, ph_hi; };
constexpr int N_PHASES = 23;

__global__ void __launch_bounds__(NWAVES * 64, 2) mk_fwd(Args args) {
    extern __shared__ __attribute__((aligned(16))) unsigned char lds_raw[];
    LAS unsigned char* lds = (LAS unsigned char*)lds_raw;
    const int G = gridDim.x, bx = blockIdx.x, NGW = G * NWAVES;
#define FRESH() int tid_ = threadIdx.x; asm volatile("" : "+v"(tid_)); const int tid = tid_, lane = tid & 63, wave = __builtin_amdgcn_readfirstlane(tid >> 6), gw = bx * NWAVES + wave; (void)tid; (void)lane; (void)gw;
    unsigned char* ws = args.ws;
    float* LB = (float*)(ws + WS_LB);
    bf16* Wb = (bf16*)(ws + WS_W);
    bf16* XN = (bf16*)(ws + WS_XN); bf16* OB = (bf16*)(ws + WS_O); bf16* HID = (bf16*)(ws + WS_HID);
    float* Y = (float*)(ws + WS_Y); float* HR = (float*)(ws + WS_H); float* Z = (float*)(ws + WS_Z);
    float* OA = (float*)(ws + WS_OA); float* OH = (float*)(ws + WS_OH);
    bf16* QB = (bf16*)(ws + WS_QB); bf16* OPB = (bf16*)(ws + WS_OP); float* LSE = (float*)(ws + WS_LSE);
    float* out = args.out;
    const int lo = args.ph_lo, hi = args.ph_hi;
#define IN(k) (lo <= (k) && (k) < hi)
#define SEAM(k) do { if (IN(k) && IN((k) + 1)) cg::this_grid().sync(); } while (0)

    if (IN(0)) {
        FRESH();
        LAS float* scr = (LAS float*)(lds + wave * 16384);
        constexpr int I_FF = (D / 64) * (FF / 32), I_DN = (FF / 64) * (D / 32), I_IN = (D / 64) * (NIN / 32), I_OUT = (D / 64) * (D / 32);
        constexpr int I_LAYER = 4 * I_FF + 2 * I_DN + I_IN + I_OUT;
        for (int it = gw; it < 2 * I_LAYER; it += NGW) {
            const int l = it / I_LAYER; int r = it % I_LAYER;
            bf16* wl = Wb + (size_t)l * W_LAYER;
            if (r < I_FF) { p0_transpose_item(args.in[6] + (size_t)l * D * FF, D, FF, wl + W_G1, 1, scr, r, lane); continue; } r -= I_FF;
            if (r < I_FF) { p0_transpose_item(args.in[7] + (size_t)l * D * FF, D, FF, wl + W_G1, 2, scr, r, lane); continue; } r -= I_FF;
            if (r < I_DN) { p0_transpose_item(args.in[8] + (size_t)l * D * FF, FF, D, wl + W_D1, 0, scr, r, lane); continue; } r -= I_DN;
            if (r < I_IN) { p0_transpose_item(args.in[11] + (size_t)l * D * NIN, D, NIN, wl + W_IN, 0, scr, r, lane); continue; } r -= I_IN;
            if (r < I_OUT) { p0_transpose_item(args.in[15] + (size_t)l * D * D, D, D, wl + W_OUT, 0, scr, r, lane); continue; } r -= I_OUT;
            if (r < I_FF) { p0_transpose_item(args.in[18] + (size_t)l * D * FF, D, FF, wl + W_G2, 1, scr, r, lane); continue; } r -= I_FF;
            if (r < I_FF) { p0_transpose_item(args.in[19] + (size_t)l * D * FF, D, FF, wl + W_G2, 2, scr, r, lane); continue; } r -= I_FF;
            p0_transpose_item(args.in[20] + (size_t)l * D * FF, FF, D, wl + W_D2, 0, scr, r, lane);
        }
        if (bx == 0) {
            const float* lg = args.in[13];
            const float x0 = lg[tid], x1 = lg[512 + tid];
            LB[tid] = 0.f; LB[512 + tid] = 1.f / (1.f + __expf(x0 - x1));
        }
        row_phase<false>(args.in[0], args.in[1], nullptr, nullptr, 0.f, nullptr, args.in[5], XN, gw, NGW, lane);
    }
    SEAM(0);

#pragma unroll 1
    for (int l = 0; l < 2; ++l) {
        const int pb = 1 + 11 * l;
        const bf16* wl = Wb + (size_t)l * W_LAYER;
        if (IN(pb + 0)) {
            pg8::Gemm g{XN, wl + W_G1, M, 2 * FF, D}; pg8::StaticOrder S; S.init(M, 2 * FF, G, bx);
            EpiSwiglu E{HID};
            pg8::gemm_phase<EpiSwiglu, pg8::StaticOrder, true, true>(lds, g, S, E);
        }
        SEAM(pb + 0);
        if (IN(pb + 1)) {
            pg8::Gemm g{HID, wl + W_D1, M, D, FF}; pg8::StaticOrder S; S.init(M, D, G, bx);
            EpiF32 E{Y, D};
            pg8::gemm_phase<EpiF32, pg8::StaticOrder, true, true>(lds, g, S, E);
        }
        SEAM(pb + 1);
        if (IN(pb + 2)) {
            FRESH();
            if (l == 0) row_phase<true>(args.in[0], args.in[1], Y, args.in[9] + l * D, 0.5f, HR, args.in[10] + l * D, XN, gw, NGW, lane);
            else        row_phase<true>(HR, nullptr, Y, args.in[9] + l * D, 0.5f, HR, args.in[10] + l * D, XN, gw, NGW, lane);
        }
        SEAM(pb + 2);
        if (IN(pb + 3)) {
            pg8::Gemm g{XN, wl + W_IN, M, NIN, D}; pg8::StaticOrder S; S.init(M, NIN, G, bx);
            EpiMix E{Z, LB + l * 512, out, l, QB};
            pg8::gemm_phase<EpiMix, pg8::StaticOrder, true, true>(lds, g, S, E);
        }
        SEAM(pb + 3);
        if (IN(pb + 4)) {
            FRESH();
            if (wave < 4) {
                LAS float* scr = (LAS float*)(lds + wave * 16384);
                const int hw = bx * 4 + wave, NHW = G * 4;
                for (int task = hw; task < 1024; task += NHW) {
                    const int seq = task >> 6, vg = task & 63, b = seq >> 2, h = seq & 3;
                    hgrn_task<32>(Z, OH, nullptr, out + OFF_SP + ((size_t)(l * 4 + b) * 4 + h) * 16384, b * SEQ, SEQ, h, vg, scr, lane);
                }
                for (int task = hw; task < 8192; task += NHW) {
                    const int b = task >> 8, h = (task >> 6) & 3, vg = task & 63;
                    const size_t so = ((size_t)(l * 32 + b) * 4 + h) * 16384;
                    hgrn_task<8>(Z, OH, args.in[4] + so, out + OFF_SS + so, MP + b * 8, 8, h, vg, scr, lane);
                }
            } else {
                const int aw = bx * 4 + (wave - 4), NAW = G * 4;
                {
                    LAS unsigned char* vimg = lds + wave * 16384;
                    constexpr int NU = 4 * 3 * 128 * 8;
                    const int per = (NU + NAW - 1) / NAW, u0 = aw * per, u1 = (u0 + per < NU) ? u0 + per : NU;
                    for (int u = u0; u < u1; ++u) attn_unit(u, QB, QB + (size_t)MP * 512, QB + (size_t)2 * MP * 512, OPB, LSE, vimg, lane);
                }
                LAS v4u* scr = (LAS v4u*)(lds + wave * 16384);
                for (int it = MP * 8 + aw; it < M * 8; it += NAW) attn_item(it >> 3, it & 7, l, Z, args.in[2], args.in[3], OA, scr, lane);
            }
        }
        SEAM(pb + 4);
        if (IN(pb + 5)) { FRESH(); r3_phase(OA, OPB, LSE, OH, Z, args.in[12] + l * 512, args.in[14] + l * 128, OB, gw, NGW, lane); }
        SEAM(pb + 5);
        if (IN(pb + 6)) {
            pg8::Gemm g{OB, wl + W_OUT, M, D, D}; pg8::StaticOrder S; S.init(M, D, G, bx);
            EpiF32 E{Y, D};
            pg8::gemm_phase<EpiF32, pg8::StaticOrder, true, true>(lds, g, S, E);
        }
        SEAM(pb + 6);
        if (IN(pb + 7)) { FRESH(); row_phase<true>(HR, nullptr, Y, args.in[16] + l * D, 1.0f, HR, args.in[17] + l * D, XN, gw, NGW, lane); }
        SEAM(pb + 7);
        if (IN(pb + 8)) {
            pg8::Gemm g{XN, wl + W_G2, M, 2 * FF, D}; pg8::StaticOrder S; S.init(M, 2 * FF, G, bx);
            EpiSwiglu E{HID};
            pg8::gemm_phase<EpiSwiglu, pg8::StaticOrder, true, true>(lds, g, S, E);
        }
        SEAM(pb + 8);
        if (IN(pb + 9)) {
            pg8::Gemm g{HID, wl + W_D2, M, D, FF}; pg8::StaticOrder S; S.init(M, D, G, bx);
            EpiF32 E{Y, D};
            pg8::gemm_phase<EpiF32, pg8::StaticOrder, true, true>(lds, g, S, E);
        }
        SEAM(pb + 9);
        if (IN(pb + 10)) {
            FRESH();
            if (l == 0) row_phase<true>(HR, nullptr, Y, args.in[21] + l * D, 0.5f, HR, args.in[5] + D, XN, gw, NGW, lane);
            else        row_phase<true>(HR, nullptr, Y, args.in[21] + l * D, 0.5f, out + OFF_Y, nullptr, nullptr, gw, NGW, lane);
        }
        SEAM(pb + 10);
    }
#undef IN
#undef SEAM
}

extern "C" void kernel_launch(void* const* d_in, const int* in_sizes, int n_in, void* d_out, int out_size, void* d_ws, size_t ws_size, hipStream_t stream) {
    static int grid = 0;
    if (grid == 0) {
        if (n_in != 22 || ws_size < WS_END) { fprintf(stderr, "kernel_launch: n_in %d ws %zu (need %zu)\n", n_in, ws_size, (size_t)WS_END); grid = -1; return; }
        int dev = 0, cus = 0, per_cu = 0;
        (void)hipGetDevice(&dev);
        (void)hipDeviceGetAttribute(&cus, hipDeviceAttributeMultiprocessorCount, dev);
        if (hipFuncSetAttribute((const void*)mk_fwd, hipFuncAttributeMaxDynamicSharedMemorySize, LDS_BYTES) != hipSuccess) { fprintf(stderr, "kernel_launch: hipFuncSetAttribute failed\n"); grid = -1; return; }
        if (hipOccupancyMaxActiveBlocksPerMultiprocessor(&per_cu, (const void*)mk_fwd, NWAVES * 64, LDS_BYTES) != hipSuccess || per_cu < 1) { fprintf(stderr, "kernel_launch: occupancy query says %d\n", per_cu); per_cu = 1; }
        (void)hipGetLastError();
        grid = cus * (per_cu > 1 ? 1 : per_cu);
        fprintf(stderr, "kernel_launch: grid %d (cus %d per_cu %d)\n", grid, cus, per_cu);
    }
    if (grid < 0) return;
    Args a{};
    for (int i = 0; i < 22; ++i) a.in[i] = (const float*)d_in[i];
    a.out = (float*)d_out; a.ws = (unsigned char*)d_ws;
#if MK_MULTI
    for (int p = 0; p < N_PHASES; ++p) {
        a.ph_lo = p; a.ph_hi = p + 1;
        void* kargs[] = {&a};
        hipError_t e = hipLaunchCooperativeKernel((const void*)mk_fwd, dim3(grid), dim3(NWAVES * 64), kargs, LDS_BYTES, stream);
        if (e != hipSuccess) { fprintf(stderr, "kernel_launch: launch %d failed: %s\n", p, hipGetErrorString(e)); break; }
    }
#else
    a.ph_lo = 0; a.ph_hi = N_PHASES;
    void* kargs[] = {&a};
    hipError_t e = hipLaunchCooperativeKernel((const void*)mk_fwd, dim3(grid), dim3(NWAVES * 64), kargs, LDS_BYTES, stream);
    if (e != hipSuccess) fprintf(stderr, "kernel_launch: cooperative launch failed: %s (grid %d)\n", hipGetErrorString(e), grid);
#endif
}
```

```cpp
#include <hip/hip_runtime.h>
#include <hip/hip_cooperative_groups.h>
#include <cstdio>
#include <cstdint>
namespace cg = cooperative_groups;

#ifndef MK_MULTI
#define MK_MULTI 0
#endif

namespace pg8 {
#define PG8_LAS __attribute__((address_space(3)))
typedef unsigned short bf16_t;
typedef short bf16x8 __attribute__((ext_vector_type(8)));
typedef float f32x4 __attribute__((ext_vector_type(4)));
typedef unsigned u32x4 __attribute__((ext_vector_type(4)));
constexpr int BM = 256, BK = 64, HALF = 128, HTB = HALF * BK * 2  , STAGE_BYTES = 8 * HTB, NXCD = 8, WGM = 8;

__host__ __device__ __forceinline__ int lds_byte(int r, int c) { const int st = (r >> 4) * 2 + (c >> 5), rr = r & 15, cc = c & 31, ob = rr * 64 + cc * 2; return st * 1024 + (ob ^ (((ob >> 9) & 1) << 5)); }
__host__ __device__ __forceinline__ void stage_rc(int b, int& R, int& C) { const int st = b / 1024, sb = b % 1024, swz = sb ^ (((sb >> 9) & 1) << 5); R = (st >> 1) * 16 + swz / 64; C = (st & 1) * 32 + (swz % 64) / 2; }
__host__ __device__ __forceinline__ int perm32(int rho) { const int n = rho >> 4, i = rho & 15; return 8 * (i >> 2) + 4 * n + (i & 3); }

struct Unit { int pm, pn; };
struct Gemm { const bf16_t* A; const bf16_t* Bt; int M, N, K; };

struct StaticOrder {
    int nM, nN, nwg, G, c;
    __host__ __device__ void init(int M, int N, int G_, int c_) { nM = M / BM; nN = N / BM; nwg = nM * nN; G = G_; c = c_; }
    __host__ __device__ bool next(int i, Unit& u) const {
        const long L = (long)i * G + c; if (L >= nwg) return false;
        int wgid = (int)L; { const int q = nwg / NXCD, r = nwg % NXCD, xcd = wgid % NXCD, off = wgid / NXCD; wgid = (xcd < r ? xcd * (q + 1) : r * (q + 1) + (xcd - r) * q) + off; }
        const int nig = WGM * nN, gid = wgid / nig, fm = gid * WGM, gsz = (nM - fm) < WGM ? (nM - fm) : WGM;
        u.pm = fm + ((wgid % nig) % gsz); u.pn = (wgid % nig) / gsz; return true;
    }
    __device__ __forceinline__ void a_ready(const Unit&) const {}
    __device__ __forceinline__ void done(const Unit&) const {}
};

template <class Epi, class Sched, bool ALIGN_EPI = false, bool SP2 = false>
__device__ __forceinline__ void gemm_phase(PG8_LAS unsigned char* lds, const Gemm g, const Sched& S, const Epi& E) {
    int tid_ = threadIdx.x; asm volatile("" : "+v"(tid_));
    const int tid = tid_, wid = __builtin_amdgcn_readfirstlane(tid >> 6), lane = tid & 63, wr = wid >> 2, wc = wid & 3, fr = lane & 15, fq = lane >> 4;
    const int K = g.K, nt = K / BK;
    unsigned voffA[2], voffB[2];
#pragma unroll
    for (int i = 0; i < 2; ++i) { int R, C; stage_rc(tid * 16 + i * 8192, R, C); const int Rb = Epi::PERM ? ((R & ~31) + perm32(R & 31)) : R;
        voffA[i] = (unsigned)(R * K + C) * 2u; voffB[i] = (unsigned)(Rb * K + C) * 2u; }
    const size_t kstep = (size_t)(BK * 2);
    const size_t hstep = (size_t)HALF * K * 2;
    const size_t tstep = 2 * hstep;
    const unsigned ldsw = (unsigned)wid * 1024u;
    const int aoff = lds_byte(wr * 64 + fr, fq * 8), boff = lds_byte(wc * 32 + fr, fq * 8);
#define PG8_SA(b, h) (((b) * 2 + (h)) * HTB)
#define PG8_SB(b, h) ((4 + (b) * 2 + (h)) * HTB)
#define PG8_STAGE(bufoff, gbase, voff) do { _Pragma("unroll") for (int _i = 0; _i < 2; ++_i) \
        __builtin_amdgcn_global_load_lds((const unsigned*)((const char*)(gbase) + (voff)[_i]), (PG8_LAS unsigned*)(lds + (bufoff) + ldsw + _i * 8192), 16, 0, 0); } while (0)
#define PG8_LDA(dst, b, h) do { _Pragma("unroll") for (int m = 0; m < 4; ++m) _Pragma("unroll") for (int k = 0; k < 2; ++k) dst[m][k] = *(const PG8_LAS bf16x8*)(lds + PG8_SA(b, h) + aoff + m * 2048 + k * 1024); } while (0)
#define PG8_LDB(dst, b, h) do { _Pragma("unroll") for (int n = 0; n < 2; ++n) _Pragma("unroll") for (int k = 0; k < 2; ++k) dst[n][k] = *(const PG8_LAS bf16x8*)(lds + PG8_SB(b, h) + boff + n * 2048 + k * 1024); } while (0)
#define PG8_MMA(ai, bj, At, Bt) do { __builtin_amdgcn_s_setprio(1); _Pragma("unroll") for (int m = 0; m < 4; ++m) _Pragma("unroll") for (int n = 0; n < 2; ++n) _Pragma("unroll") for (int k = 0; k < 2; ++k) \
        acc[ai][bj][m][n] = __builtin_amdgcn_mfma_f32_16x16x32_bf16(Bt[n][k], At[m][k], acc[ai][bj][m][n], 0, 0, 0); __builtin_amdgcn_s_setprio(0); } while (0)
#define PG8_WAIT_V(n) asm volatile("s_waitcnt vmcnt(" #n ")" ::: "memory")
#define PG8_WAIT_L(n) asm volatile("s_waitcnt lgkmcnt(" #n ")" ::: "memory")
#define PG8_BAR __builtin_amdgcn_s_barrier()
#define PG8_SCHED __builtin_amdgcn_sched_barrier(0)
    Unit cur, nxt; int ui = 0;
    if (!S.next(0, cur)) return;
    f32x4 acc[2][2][4][2];
#pragma unroll
    for (int a = 0; a < 2; ++a)
#pragma unroll
        for (int b = 0; b < 2; ++b)
#pragma unroll
            for (int m = 0; m < 4; ++m)
#pragma unroll
                for (int n = 0; n < 2; ++n) acc[a][b][m][n] = (f32x4){0.f, 0.f, 0.f, 0.f};
    bf16x8 At[4][2], B0[2][2], B1[2][2];
    const char* cA = (const char*)g.A + (size_t)cur.pm * tstep; const char* cB = (const char*)g.Bt + (size_t)cur.pn * tstep;
    S.a_ready(cur);
    if constexpr (SP2) {
        PG8_STAGE(PG8_SB(0, 0), cB, voffB); PG8_STAGE(PG8_SB(0, 1), cB + hstep, voffB); PG8_STAGE(PG8_SA(0, 0), cA, voffA); PG8_STAGE(PG8_SA(0, 1), cA + hstep, voffA);
        if (wr == 1) PG8_BAR;
        PG8_WAIT_V(2); PG8_BAR;
        PG8_STAGE(PG8_SB(1, 0), cB + kstep, voffB); PG8_STAGE(PG8_SA(1, 0), cA + kstep, voffA); PG8_STAGE(PG8_SB(1, 1), cB + hstep + kstep, voffB);
        PG8_WAIT_V(6); PG8_BAR;
    } else {
        PG8_STAGE(PG8_SB(0, 0), cB, voffB); PG8_STAGE(PG8_SA(0, 0), cA, voffA); PG8_STAGE(PG8_SB(0, 1), cB + hstep, voffB); PG8_STAGE(PG8_SA(0, 1), cA + hstep, voffA);
        if (wr == 1) PG8_BAR;
        PG8_WAIT_V(4); PG8_BAR;
        PG8_STAGE(PG8_SB(1, 0), cB + kstep, voffB); PG8_STAGE(PG8_SA(1, 0), cA + kstep, voffA); PG8_STAGE(PG8_SB(1, 1), cB + hstep + kstep, voffB);
        PG8_WAIT_V(6); PG8_BAR;
    }
    for (;;) {
        const bool has_next = S.next(ui + 1, nxt);
        const char* nA = has_next ? (const char*)g.A + (size_t)nxt.pm * tstep : cA; const char* nB = has_next ? (const char*)g.Bt + (size_t)nxt.pn * tstep : cB;
        for (int t = 0; t < nt; t += 2) {
            const bool last = (t == nt - 2);
            const char* a1 = cA + (size_t)(t + 1) * kstep;
            const char* a2 = last ? nA : cA + (size_t)(t + 2) * kstep; const char* b2 = last ? nB : cB + (size_t)(t + 2) * kstep;
            const char* a3 = a2 + kstep; const char* b3 = b2 + kstep;
            if (last && has_next) S.a_ready(nxt);
            if constexpr (SP2) {
            PG8_LDB(B0, 0, 0); PG8_LDB(B1, 0, 1); PG8_SCHED; PG8_LDA(At, 0, 0); PG8_STAGE(PG8_SA(1, 1), a1 + hstep, voffA);
            PG8_WAIT_V(8); PG8_WAIT_L(0); PG8_BAR; PG8_MMA(0, 0, At, B0); PG8_MMA(0, 1, At, B1); PG8_BAR; PG8_SCHED;
            PG8_LDA(At, 0, 1); PG8_STAGE(PG8_SB(0, 0), b2, voffB); PG8_STAGE(PG8_SB(0, 1), b2 + hstep, voffB); PG8_STAGE(PG8_SA(0, 0), a2, voffA);
            PG8_WAIT_V(8); PG8_WAIT_L(0); PG8_BAR; PG8_MMA(1, 0, At, B0); PG8_MMA(1, 1, At, B1); PG8_BAR; PG8_SCHED;
            PG8_LDB(B0, 1, 0); PG8_LDB(B1, 1, 1); PG8_SCHED; PG8_LDA(At, 1, 0); PG8_STAGE(PG8_SA(0, 1), a2 + hstep, voffA);
            PG8_WAIT_V(8); PG8_WAIT_L(0); PG8_BAR; PG8_MMA(0, 0, At, B0); PG8_MMA(0, 1, At, B1); PG8_BAR; PG8_SCHED;
            PG8_LDA(At, 1, 1); PG8_STAGE(PG8_SB(1, 0), b3, voffB); PG8_STAGE(PG8_SB(1, 1), b3 + hstep, voffB); PG8_STAGE(PG8_SA(1, 0), a3, voffA);
            PG8_WAIT_V(8); PG8_WAIT_L(0); PG8_BAR; PG8_MMA(1, 0, At, B0); PG8_MMA(1, 1, At, B1); PG8_BAR; PG8_SCHED;
            } else {
            PG8_LDB(B0, 0, 0); PG8_SCHED; PG8_LDA(At, 0, 0); PG8_STAGE(PG8_SA(1, 1), a1 + hstep, voffA);
            PG8_WAIT_L(8); PG8_BAR; PG8_WAIT_L(0); PG8_MMA(0, 0, At, B0); PG8_BAR; PG8_SCHED;
            PG8_LDB(B1, 0, 1); PG8_STAGE(PG8_SB(0, 0), b2, voffB);
            PG8_BAR; PG8_WAIT_L(0); PG8_MMA(0, 1, At, B1); PG8_BAR;
            PG8_LDA(At, 0, 1); PG8_STAGE(PG8_SA(0, 0), a2, voffA);
            PG8_BAR; PG8_WAIT_L(0); PG8_MMA(1, 0, At, B0); PG8_BAR; PG8_SCHED;
            PG8_STAGE(PG8_SB(0, 1), b2 + hstep, voffB);
            PG8_WAIT_V(6); PG8_BAR; PG8_MMA(1, 1, At, B1); PG8_BAR;
            PG8_LDB(B0, 1, 0); PG8_SCHED; PG8_LDA(At, 1, 0); PG8_STAGE(PG8_SA(0, 1), a2 + hstep, voffA);
            PG8_WAIT_L(8); PG8_BAR; PG8_WAIT_L(0); PG8_MMA(0, 0, At, B0); PG8_BAR; PG8_SCHED;
            PG8_LDB(B1, 1, 1); PG8_STAGE(PG8_SB(1, 0), b3, voffB);
            PG8_BAR; PG8_WAIT_L(0); PG8_MMA(0, 1, At, B1); PG8_BAR;
            PG8_LDA(At, 1, 1); PG8_STAGE(PG8_SA(1, 0), a3, voffA);
            PG8_BAR; PG8_WAIT_L(0); PG8_MMA(1, 0, At, B0); PG8_BAR; PG8_SCHED;
            PG8_STAGE(PG8_SB(1, 1), b3 + hstep, voffB);
            PG8_WAIT_V(6); PG8_BAR; PG8_MMA(1, 1, At, B1); PG8_BAR;
            }
        }
        if constexpr (ALIGN_EPI) { if (wr == 0) PG8_BAR; }
        if constexpr (!Epi::AFTER_DRAIN) { E(acc, cur, wr, wc, fr, fq); S.done(cur); }
        if (!has_next) break;
#pragma unroll
        for (int a = 0; a < 2; ++a)
#pragma unroll
            for (int b = 0; b < 2; ++b)
#pragma unroll
                for (int m = 0; m < 4; ++m)
#pragma unroll
                    for (int n = 0; n < 2; ++n) acc[a][b][m][n] = (f32x4){0.f, 0.f, 0.f, 0.f};
        cur = nxt; cA = nA; cB = nB; ++ui;
        if constexpr (ALIGN_EPI) { if (wr == 1) PG8_BAR; }
    }
    PG8_WAIT_V(0);
    if constexpr (!ALIGN_EPI) { if (wr == 0) PG8_BAR; }
    PG8_BAR;
    if constexpr (Epi::AFTER_DRAIN) { E.fused(acc, cur, wr, wc, fr, fq, lds, wid, lane); S.done(cur); }
#undef PG8_SA
#undef PG8_SB
#undef PG8_STAGE
#undef PG8_LDA
#undef PG8_LDB
#undef PG8_MMA
#undef PG8_WAIT_V
#undef PG8_WAIT_L
#undef PG8_BAR
#undef PG8_SCHED
}
}

constexpr int NWAVES = 8;
constexpr int D = 1024, FF = 2816, NIN = 3584, MP = 16384, MS = 256, M = MP + MS, SEQ = 4096;
constexpr int SEG_Q = 0, SEG_K = 512, SEG_V = 1024, SEG_BQ = 1536, SEG_BF = 2048, SEG_BI = 2560, SEG_BG = 3072;
constexpr float EPS = 1e-6f;
constexpr size_t OFF_Y = 0, OFF_KP = 17039360, OFF_VP = 25427968, OFF_SP = 33816576, OFF_KS = 34340864, OFF_VS = 34603008, OFF_SS = 34865152;
constexpr size_t MiB = 1u << 20;
constexpr size_t WS_LB = 0;
constexpr size_t WS_BAR = 65536;
constexpr size_t WS_W = 1 * MiB;
constexpr size_t W_G1 = 0, W_D1 = W_G1 + (size_t)2 * FF * D, W_IN = W_D1 + (size_t)D * FF, W_OUT = W_IN + (size_t)NIN * D,
                 W_G2 = W_OUT + (size_t)D * D, W_D2 = W_G2 + (size_t)2 * FF * D, W_LAYER = W_D2 + (size_t)D * FF;
constexpr size_t WS_XN = WS_W + 2 * W_LAYER * 2;
constexpr size_t WS_O = WS_XN + (size_t)M * D * 2;
constexpr size_t WS_HID = WS_O + (size_t)M * D * 2;
constexpr size_t WS_Y = WS_HID + (size_t)M * FF * 2;
constexpr size_t WS_H = WS_Y + (size_t)M * D * 4;
constexpr size_t WS_Z = WS_H + (size_t)M * D * 4;
constexpr size_t WS_OA = WS_Z + (size_t)M * NIN * 4;
constexpr size_t WS_OH = WS_OA + (size_t)M * 512 * 4;
constexpr size_t WS_QB = WS_OH + (size_t)M * 512 * 4;
constexpr size_t WS_KB = WS_QB + (size_t)MP * 512 * 2;
constexpr size_t WS_VB = WS_KB + (size_t)MP * 512 * 2;
constexpr size_t WS_OP = WS_VB + (size_t)MP * 512 * 2;
constexpr size_t WS_LSE = WS_OP + (size_t)3 * MP * 512 * 2;
constexpr size_t WS_END = WS_LSE + (size_t)3 * MP * 8 * 4;
constexpr int LDS_BYTES = 147456;

#define GAS __attribute__((address_space(1)))
#define LAS __attribute__((address_space(3)))
typedef unsigned short bf16;
typedef unsigned v4u __attribute__((ext_vector_type(4)));
typedef float f32x4 __attribute__((ext_vector_type(4)));
#define LDS_WAIT() asm volatile("s_waitcnt lgkmcnt(0)" ::: "memory")

__device__ __forceinline__ unsigned f2bf(float f) { unsigned u = __builtin_bit_cast(unsigned, f); return (u + 0x7fffu + ((u >> 16) & 1u)) >> 16; }
__device__ __forceinline__ unsigned pk2(float lo, float hi) { return f2bf(lo) | (f2bf(hi) << 16); }
__device__ __forceinline__ float silu_f(float x) { return x * __frcp_rn(1.f + __expf(-x)); }
__device__ __forceinline__ float sigmoid_f(float x) { return __frcp_rn(1.f + __expf(-x)); }
__device__ __forceinline__ float wave_sum(float v) {
#pragma unroll
    for (int o = 1; o < 64; o <<= 1) v += __shfl_xor(v, o);
    return v;
}
__device__ __forceinline__ float wave_max(float v) {
#pragma unroll
    for (int o = 1; o < 64; o <<= 1) v = fmaxf(v, __shfl_xor(v, o));
    return v;
}

struct EpiSwiglu {
    static constexpr bool PERM = true, AFTER_DRAIN = false;
    bf16* H;
    __device__ __forceinline__ void operator()(const pg8::f32x4 (&acc)[2][2][4][2], const pg8::Unit& u, int wr, int wc, int fr, int fq) const {
        const int row0 = u.pm * 256 + wr * 64 + fr, col0 = u.pn * 128 + wc * 32 + 8 * fq;
#pragma unroll
        for (int ai = 0; ai < 2; ++ai)
#pragma unroll
            for (int m = 0; m < 4; ++m) {
                bf16* rowp = H + (size_t)(row0 + ai * 128 + m * 16) * FF + col0;
                const pg8::f32x4 g0 = acc[ai][0][m][0], g1 = acc[ai][0][m][1], u0 = acc[ai][1][m][0], u1 = acc[ai][1][m][1];
                v4u w;
                w.x = pk2(silu_f(g0[0]) * u0[0], silu_f(g0[1]) * u0[1]); w.y = pk2(silu_f(g0[2]) * u0[2], silu_f(g0[3]) * u0[3]);
                w.z = pk2(silu_f(g1[0]) * u1[0], silu_f(g1[1]) * u1[1]); w.w = pk2(silu_f(g1[2]) * u1[2], silu_f(g1[3]) * u1[3]);
                *(v4u*)rowp = w;
            }
    }
};
struct EpiF32 {
    static constexpr bool PERM = true, AFTER_DRAIN = false;
    float* Y; int ldc;
    __device__ __forceinline__ void operator()(const pg8::f32x4 (&acc)[2][2][4][2], const pg8::Unit& u, int wr, int wc, int fr, int fq) const {
        const int row0 = u.pm * 256 + wr * 64 + fr, col0 = u.pn * 256 + wc * 32 + 8 * fq;
#pragma unroll
        for (int ai = 0; ai < 2; ++ai)
#pragma unroll
            for (int m = 0; m < 4; ++m) {
                float* rowp = Y + (size_t)(row0 + ai * 128 + m * 16) * ldc + col0;
#pragma unroll
                for (int bj = 0; bj < 2; ++bj)
#pragma unroll
                    for (int n = 0; n < 2; ++n) *(f32x4*)(rowp + bj * 128 + 4 * n) = acc[ai][bj][m][n];
            }
    }
};
struct EpiMix {
    static constexpr bool PERM = true, AFTER_DRAIN = false;
    float* Z; const float* lb; float* out; int l; bf16* QKV;
    __device__ __forceinline__ void operator()(const pg8::f32x4 (&acc)[2][2][4][2], const pg8::Unit& u, int wr, int wc, int fr, int fq) const {
        const int seg = u.pn >> 1;
        const int row0 = u.pm * 256 + wr * 64 + fr, cs0 = (u.pn & 1) * 256 + wc * 32 + 8 * fq;
        f32x4 lbv[2][2];
#pragma unroll
        for (int bj = 0; bj < 2; ++bj)
#pragma unroll
            for (int n = 0; n < 2; ++n) lbv[bj][n] = (seg == 4) ? *(const f32x4*)(lb + cs0 + bj * 128 + 4 * n) : (f32x4){0.f, 0.f, 0.f, 0.f};
#pragma unroll
        for (int ai = 0; ai < 2; ++ai)
#pragma unroll
            for (int m = 0; m < 4; ++m) {
                const int row = row0 + ai * 128 + m * 16;
                float* zrow = Z + (size_t)row * NIN + seg * 512 + cs0;
                float* orow = nullptr;
                f32x4 vv[2][2];
                if (seg == 1 || seg == 2) {
                    if (row < MP) { const int b = row >> 12, t = row & 4095;
                        if (t >= 2048) orow = out + (seg == 1 ? OFF_KP : OFF_VP) + ((size_t)(l * 4 + b) * 2048 + (t - 2048)) * 512 + cs0; }
                    else orow = out + (seg == 1 ? OFF_KS : OFF_VS) + ((size_t)l * 256 + (row - MP)) * 512 + cs0;
                }
#pragma unroll
                for (int bj = 0; bj < 2; ++bj)
#pragma unroll
                    for (int n = 0; n < 2; ++n) {
                        f32x4 v = acc[ai][bj][m][n];
                        if (seg == 0) v = v * 0.125f;
                        else if (seg == 3 || seg == 6) { v[0] = silu_f(v[0]); v[1] = silu_f(v[1]); v[2] = silu_f(v[2]); v[3] = silu_f(v[3]); }
                        else if (seg == 4) {
                            const f32x4 b4 = lbv[bj][n];
#pragma unroll
                            for (int i = 0; i < 4; ++i) v[i] = b4[i] + (1.f - b4[i]) * sigmoid_f(v[i]);
                        }
                        if (!(seg < 3 && row < MP)) *(f32x4*)(zrow + bj * 128 + 4 * n) = v;
                        if (orow) *(f32x4*)(orow + bj * 128 + 4 * n) = v;
                        vv[bj][n] = v;
                    }
                if (seg < 3 && row < MP) {
                    bf16* qrow = QKV + (size_t)seg * MP * 512 + (size_t)row * 512 + cs0;
#pragma unroll
                    for (int bj = 0; bj < 2; ++bj) { v4u w; w.x = pk2(vv[bj][0][0], vv[bj][0][1]); w.y = pk2(vv[bj][0][2], vv[bj][0][3]); w.z = pk2(vv[bj][1][0], vv[bj][1][1]); w.w = pk2(vv[bj][1][2], vv[bj][1][3]);
                        *(v4u*)(qrow + bj * 128) = w; }
                }
            }
    }
};

__device__ __forceinline__ void p0_transpose_item(const float* W, int K, int N, bf16* WT, int mode, LAS float* scr, int item, int lane) {
    const int nblk = N / 32, kb = item / nblk, nb = item % nblk, k0 = 64 * kb, n0 = 32 * nb;
    const int r0 = (mode == 0) ? n0 : ((n0 >> 7) * 256 + (mode - 1) * 128 + (n0 & 127));
#pragma unroll 8
    for (int i = 0; i < 32; ++i) { const int kk = 2 * i + (lane >> 5); scr[kk * 33 + (lane & 31)] = W[(size_t)(k0 + kk) * N + n0 + (lane & 31)]; }
    LDS_WAIT(); asm volatile("" ::: "memory");
    const int c = lane & 7;
#pragma unroll
    for (int j = 0; j < 4; ++j) { const int n = (lane >> 3) + 8 * j; const LAS float* s = scr + (8 * c) * 33 + n;
        v4u o; o.x = pk2(s[0 * 33], s[1 * 33]); o.y = pk2(s[2 * 33], s[3 * 33]); o.z = pk2(s[4 * 33], s[5 * 33]); o.w = pk2(s[6 * 33], s[7 * 33]);
        *(v4u*)(WT + (size_t)(r0 + n) * K + k0 + 8 * c) = o; }
    LDS_WAIT(); asm volatile("" ::: "memory");
}

template <bool HAS_Y>
__device__ __forceinline__ void row_phase(const float* res_p, const float* res_s  , const float* Y, const float* post_g, float coef,
                                          float* hout, const float* pre_g, bf16* xn, int gw, int NGW, int lane) {
    for (int row = gw; row < M; row += NGW) {
        const float* rp = (res_s && row >= MP) ? res_s + (size_t)(row - MP) * D : res_p + (size_t)row * D;
        f32x4 v[4];
#pragma unroll
        for (int j = 0; j < 4; ++j) v[j] = *((const f32x4*)rp + lane + 64 * j);
        if (HAS_Y) {
            f32x4 y[4]; float s = 0.f;
#pragma unroll
            for (int j = 0; j < 4; ++j) { y[j] = *((const f32x4*)(Y + (size_t)row * D) + lane + 64 * j); s += (y[j][0] * y[j][0] + y[j][1] * y[j][1]) + (y[j][2] * y[j][2] + y[j][3] * y[j][3]); }
            const float rstd = coef * rsqrtf(wave_sum(s) * (1.f / D) + EPS);
#pragma unroll
            for (int j = 0; j < 4; ++j) { const f32x4 g = *((const f32x4*)post_g + lane + 64 * j); v[j] = v[j] + y[j] * g * rstd; }
        }
        if (hout) {
#pragma unroll
            for (int j = 0; j < 4; ++j) *((f32x4*)(hout + (size_t)row * D) + lane + 64 * j) = v[j];
        }
        if (pre_g) {
            float s = 0.f;
#pragma unroll
            for (int j = 0; j < 4; ++j) s += (v[j][0] * v[j][0] + v[j][1] * v[j][1]) + (v[j][2] * v[j][2] + v[j][3] * v[j][3]);
            const float rstd = rsqrtf(wave_sum(s) * (1.f / D) + EPS);
            unsigned long long* o8 = (unsigned long long*)(xn + (size_t)row * D) + lane;
#pragma unroll
            for (int j = 0; j < 4; ++j) { const f32x4 g = *((const f32x4*)pre_g + lane + 64 * j); const f32x4 w = v[j] * g * rstd;
                o8[64 * j] = (unsigned long long)pk2(w[0], w[1]) | ((unsigned long long)pk2(w[2], w[3]) << 32); }
        }
    }
}

__device__ __forceinline__ float bflo(unsigned u) { return __builtin_bit_cast(float, u << 16); }
__device__ __forceinline__ float bfhi(unsigned u) { return __builtin_bit_cast(float, u & 0xffff0000u); }
__device__ __forceinline__ void r3_phase(const float* OA, const bf16* OP, const float* LSE, const float* OH, const float* Z, const float* attn_g, const float* hgrn_g, bf16* O, int gw, int NGW, int lane) {
    for (int row = gw; row < M; row += NGW) {
        f32x4 a0, a1;
        if (row < MP) {
            const int hd = lane >> 3;
            const float l0 = LSE[((size_t)0 * MP + row) * 8 + hd], l1 = LSE[((size_t)1 * MP + row) * 8 + hd], l2 = LSE[((size_t)2 * MP + row) * 8 + hd];
            const float mx = fmaxf(l0, fmaxf(l1, l2));
            float w0 = __expf(l0 - mx), w1 = __expf(l1 - mx), w2 = __expf(l2 - mx);
            const float iw = 1.f / (w0 + w1 + w2); w0 *= iw; w1 *= iw; w2 *= iw;
            const v4u p0 = *((const v4u*)(OP + ((size_t)0 * MP + row) * 512) + lane), p1 = *((const v4u*)(OP + ((size_t)1 * MP + row) * 512) + lane), p2 = *((const v4u*)(OP + ((size_t)2 * MP + row) * 512) + lane);
            a0[0] = w0 * bflo(p0.x) + w1 * bflo(p1.x) + w2 * bflo(p2.x); a0[1] = w0 * bfhi(p0.x) + w1 * bfhi(p1.x) + w2 * bfhi(p2.x);
            a0[2] = w0 * bflo(p0.y) + w1 * bflo(p1.y) + w2 * bflo(p2.y); a0[3] = w0 * bfhi(p0.y) + w1 * bfhi(p1.y) + w2 * bfhi(p2.y);
            a1[0] = w0 * bflo(p0.z) + w1 * bflo(p1.z) + w2 * bflo(p2.z); a1[1] = w0 * bfhi(p0.z) + w1 * bfhi(p1.z) + w2 * bfhi(p2.z);
            a1[2] = w0 * bflo(p0.w) + w1 * bflo(p1.w) + w2 * bflo(p2.w); a1[3] = w0 * bfhi(p0.w) + w1 * bfhi(p1.w) + w2 * bfhi(p2.w);
        } else {
            a0 = *((const f32x4*)(OA + (size_t)row * 512) + 2 * lane); a1 = *((const f32x4*)(OA + (size_t)row * 512) + 2 * lane + 1);
        }
        const f32x4 h0 = *((const f32x4*)(OH + (size_t)row * 512) + 2 * lane), h1 = *((const f32x4*)(OH + (size_t)row * 512) + 2 * lane + 1);
        const f32x4 g0 = *((const f32x4*)(Z + (size_t)row * NIN + SEG_BG) + 2 * lane), g1 = *((const f32x4*)(Z + (size_t)row * NIN + SEG_BG) + 2 * lane + 1);
        float sa = (a0[0] * a0[0] + a0[1] * a0[1]) + (a0[2] * a0[2] + a0[3] * a0[3]) + (a1[0] * a1[0] + a1[1] * a1[1]) + (a1[2] * a1[2] + a1[3] * a1[3]);
        float sh = (h0[0] * h0[0] + h0[1] * h0[1]) + (h0[2] * h0[2] + h0[3] * h0[3]) + (h1[0] * h1[0] + h1[1] * h1[1]) + (h1[2] * h1[2] + h1[3] * h1[3]);
        sa = wave_sum(sa);
#pragma unroll
        for (int o = 1; o < 16; o <<= 1) sh += __shfl_xor(sh, o);
        const float ra = rsqrtf(sa * (1.f / 512.f) + EPS), rh = rsqrtf(sh * (1.f / 128.f) + EPS);
        const f32x4 ag0 = *((const f32x4*)attn_g + 2 * lane), ag1 = *((const f32x4*)attn_g + 2 * lane + 1);
        const f32x4 hg0 = *((const f32x4*)hgrn_g + 2 * (lane & 15)), hg1 = *((const f32x4*)hgrn_g + 2 * (lane & 15) + 1);
        const f32x4 oa0 = a0 * ag0 * ra, oa1 = a1 * ag1 * ra, ob0 = h0 * hg0 * rh * g0, ob1 = h1 * hg1 * rh * g1;
        v4u wa, wb;
        wa.x = pk2(oa0[0], oa0[1]); wa.y = pk2(oa0[2], oa0[3]); wa.z = pk2(oa1[0], oa1[1]); wa.w = pk2(oa1[2], oa1[3]);
        wb.x = pk2(ob0[0], ob0[1]); wb.y = pk2(ob0[2], ob0[3]); wb.z = pk2(ob1[0], ob1[1]); wb.w = pk2(ob1[2], ob1[3]);
        *((v4u*)(O + (size_t)row * D) + lane) = wa;
        *((v4u*)(O + (size_t)row * D + 512) + lane) = wb;
    }
}

typedef float f32x2 __attribute__((ext_vector_type(2)));
struct HgIn { f32x4 f, q; float v; };
__device__ __forceinline__ void hg_load(HgIn (&d)[4], const float* Z, int rowbase, int t0, int T, int h, int kq, int vcol) {
#pragma unroll
    for (int i = 0; i < 4; ++i) {
        int t = t0 + i; t = t < T ? t : T - 1;
        const float* zr = Z + (size_t)(rowbase + t) * NIN + h * 128;
        d[i].f = *(const f32x4*)(zr + SEG_BF + kq * 4); d[i].q = *(const f32x4*)(zr + SEG_BQ + kq * 4);
        d[i].v = zr[SEG_BI + vcol];
    }
}
__device__ __forceinline__ void hg_step4(const HgIn (&d)[4], f32x2& Sa, f32x2& Sb, LAS float* scr, int slot0, int lane) {
#pragma unroll
    for (int i = 0; i < 4; ++i) {
        const f32x2 vv = {d[i].v, d[i].v};
        const f32x2 fa = {d[i].f[0], d[i].f[1]}, fb = {d[i].f[2], d[i].f[3]}, qa = {d[i].q[0], d[i].q[1]}, qb = {d[i].q[2], d[i].q[3]};
        Sa = fa * (Sa - vv) + vv; Sb = fb * (Sb - vv) + vv;
        const f32x2 pr = qa * Sa + qb * Sb;
        scr[(slot0 + i) * 64 + lane] = pr[0] + pr[1];
    }
}
template <int BS>
__device__ __forceinline__ void hgrn_task(const float* Z, float* OH, const float* s0, float* sout, int rowbase, int T, int h, int vg, LAS float* scr, int lane) {
    const int kq = lane & 31, g = lane >> 5, vcol = vg * 2 + g;
    f32x2 Sa, Sb;
    Sa[0] = s0 ? s0[(size_t)(kq * 4 + 0) * 128 + vcol] : 0.f; Sa[1] = s0 ? s0[(size_t)(kq * 4 + 1) * 128 + vcol] : 0.f;
    Sb[0] = s0 ? s0[(size_t)(kq * 4 + 2) * 128 + vcol] : 0.f; Sb[1] = s0 ? s0[(size_t)(kq * 4 + 3) * 128 + vcol] : 0.f;
    HgIn A[4], B[4];
    hg_load(A, Z, rowbase, 0, T, h, kq, vcol);
    for (int t0 = 0; t0 < T; t0 += BS) {
#pragma unroll 1
        for (int u = 0; u < BS; u += 8) {
            hg_load(B, Z, rowbase, t0 + u + 4, T, h, kq, vcol);
            hg_step4(A, Sa, Sb, scr, u, lane);
            hg_load(A, Z, rowbase, t0 + u + 8, T, h, kq, vcol);
            hg_step4(B, Sa, Sb, scr, u + 4, lane);
        }
        __builtin_amdgcn_wave_barrier(); LDS_WAIT();
        if (kq < BS) {
            float sum = 0.f;
#pragma unroll 8
            for (int i = 0; i < 32; ++i) sum += scr[kq * 64 + g * 32 + ((i + kq) & 31)];
            OH[(size_t)(rowbase + t0 + kq) * 512 + h * 128 + vcol] = sum;
        }
        __builtin_amdgcn_wave_barrier(); LDS_WAIT();
    }
    sout[(size_t)(kq * 4 + 0) * 128 + vcol] = Sa[0]; sout[(size_t)(kq * 4 + 1) * 128 + vcol] = Sa[1];
    sout[(size_t)(kq * 4 + 2) * 128 + vcol] = Sb[0]; sout[(size_t)(kq * 4 + 3) * 128 + vcol] = Sb[1];
}

typedef short bf16x8 __attribute__((ext_vector_type(8)));
typedef float f32x16 __attribute__((ext_vector_type(16)));
typedef float f32x2_t __attribute__((ext_vector_type(2))); typedef __bf16 bf16x2_t __attribute__((ext_vector_type(2)));
__device__ __forceinline__ unsigned cvtpk(float lo, float hi) { f32x2_t v = {lo, hi}; bf16x2_t b = __builtin_convertvector(v, bf16x2_t); return __builtin_bit_cast(unsigned, b); }
#define MFMA32(a, b, c) __builtin_amdgcn_mfma_f32_32x32x16_bf16((a), (b), (c), 0, 0, 0)
__device__ __forceinline__ void attn_unit(int u, const bf16* QB, const bf16* KB, const bf16* VB, bf16* OP, float* LSE, LAS unsigned char* vimg, int lane) {
    const int h = u & 7; int t = u >> 3; const int tile = t & 127; t >>= 7; const int p = t % 3, b = t / 3;
    const int sh = 2 * p, r = tile >> (7 - sh), qt = tile & ((128 >> sh) - 1);
    const int c = lane & 31, hi = lane >> 5;
    const int qrow = b * SEQ + ((32 * qt + c) << sh) + r;
    bf16x8 qf[4];
#pragma unroll
    for (int ks = 0; ks < 4; ++ks) qf[ks] = *(const bf16x8*)(QB + (size_t)qrow * 512 + h * 64 + ks * 16 + hi * 8);
    f32x16 o0, o1;
#pragma unroll
    for (int i = 0; i < 16; ++i) { o0[i] = 0.f; o1[i] = 0.f; }
    float m = -INFINITY, l = 0.f;
    const int pr = (c & 0x13) | ((c & 8) >> 1) | ((c & 4) << 1);
    const int kt0 = (qt >= 4) ? 0 : 4 - qt;
#pragma unroll 1
    for (int kt = kt0; kt < 5; ++kt) {
        const int kb = 32 * qt - 128 + 32 * kt;
        const int krow = b * SEQ + ((kb + pr) << sh) + r, vrow = b * SEQ + ((kb + c) << sh) + r;
        bf16x8 kf[4], vf[4];
#pragma unroll
        for (int ks = 0; ks < 4; ++ks) kf[ks] = *(const bf16x8*)(KB + (size_t)krow * 512 + h * 64 + ks * 16 + hi * 8);
#pragma unroll
        for (int ks = 0; ks < 4; ++ks) vf[ks] = *(const bf16x8*)(VB + (size_t)vrow * 512 + h * 64 + ks * 16 + hi * 8);
        f32x16 s;
#pragma unroll
        for (int i = 0; i < 16; ++i) s[i] = 0.f;
#pragma unroll
        for (int ks = 0; ks < 4; ++ks) s = MFMA32(kf[ks], qf[ks], s);
#pragma unroll
        for (int ks = 0; ks < 4; ++ks)
#pragma unroll
            for (int e = 0; e < 8; ++e) *(LAS short*)(vimg + (ks * 16 + hi * 8 + e) * 80 + c * 2) = vf[ks][e];
        if (kt == 0) {
#pragma unroll
            for (int i = 0; i < 16; ++i) { const int ko = 16 * (i >> 3) + 8 * hi + (i & 7); s[i] = (ko >= c) ? s[i] : -INFINITY; }
        } else if (kt == 4) {
#pragma unroll
            for (int i = 0; i < 16; ++i) { const int ko = 16 * (i >> 3) + 8 * hi + (i & 7); s[i] = (ko <= c) ? s[i] : -INFINITY; }
        }
        float tmax = s[0];
#pragma unroll
        for (int i = 1; i < 16; ++i) tmax = fmaxf(tmax, s[i]);
        tmax = fmaxf(tmax, __shfl_xor(tmax, 32));
        const float mn = fmaxf(m, tmax), alpha = __expf(m - mn);
        float ls = 0.f;
#pragma unroll
        for (int i = 0; i < 16; ++i) { s[i] = __expf(s[i] - mn); ls += s[i]; }
        ls += __shfl_xor(ls, 32);
        l = l * alpha + ls; m = mn;
#pragma unroll
        for (int i = 0; i < 16; ++i) { o0[i] *= alpha; o1[i] *= alpha; }
        bf16x8 pf[2];
#pragma unroll
        for (int s2 = 0; s2 < 2; ++s2) { v4u w; w.x = cvtpk(s[8 * s2 + 0], s[8 * s2 + 1]); w.y = cvtpk(s[8 * s2 + 2], s[8 * s2 + 3]); w.z = cvtpk(s[8 * s2 + 4], s[8 * s2 + 5]); w.w = cvtpk(s[8 * s2 + 6], s[8 * s2 + 7]);
            pf[s2] = __builtin_bit_cast(bf16x8, w); }
        __builtin_amdgcn_wave_barrier(); LDS_WAIT();
#pragma unroll
        for (int s2 = 0; s2 < 2; ++s2) {
            const bf16x8 a0 = *(const LAS bf16x8*)(vimg + c * 80 + (16 * s2 + 8 * hi) * 2);
            const bf16x8 a1 = *(const LAS bf16x8*)(vimg + (32 + c) * 80 + (16 * s2 + 8 * hi) * 2);
            o0 = MFMA32(a0, pf[s2], o0); o1 = MFMA32(a1, pf[s2], o1);
        }
        __builtin_amdgcn_wave_barrier(); LDS_WAIT();
    }
    const float inv = 1.f / l;
    bf16* orow = OP + ((size_t)p * MP + qrow) * 512 + h * 64;
#pragma unroll
    for (int gq = 0; gq < 4; ++gq) {
        unsigned long long w0 = (unsigned long long)cvtpk(o0[4 * gq] * inv, o0[4 * gq + 1] * inv) | ((unsigned long long)cvtpk(o0[4 * gq + 2] * inv, o0[4 * gq + 3] * inv) << 32);
        unsigned long long w1 = (unsigned long long)cvtpk(o1[4 * gq] * inv, o1[4 * gq + 1] * inv) | ((unsigned long long)cvtpk(o1[4 * gq + 2] * inv, o1[4 * gq + 3] * inv) << 32);
        *(unsigned long long*)(orow + 8 * gq + 4 * hi) = w0;
        *(unsigned long long*)(orow + 32 + 8 * gq + 4 * hi) = w1;
    }
    if (hi == 0) LSE[((size_t)p * MP + qrow) * 8 + h] = m + __logf(l);
}

__device__ __forceinline__ const float* kv_ptr(bool samp, int b, int idx, int h, int seg, const float* Z, const float* cache, int l) {
    if (!samp) return Z + (size_t)(b * SEQ + idx) * NIN + seg + h * 64;
    if (idx >= 2048) return Z + (size_t)(MP + b * 8 + (idx - 2048)) * NIN + seg + h * 64;
    return cache + ((((size_t)l * 32 + b) * 2048 + idx) * 8 + h) * 64;
}
__device__ __forceinline__ float dot64(const f32x4 (&q)[16], const float* kp) {
    float a0 = 0.f, a1 = 0.f, a2 = 0.f, a3 = 0.f;
#pragma unroll
    for (int i = 0; i < 16; ++i) { const f32x4 k = *((const f32x4*)kp + i); a0 = fmaf(q[i][0], k[0], a0); a1 = fmaf(q[i][1], k[1], a1); a2 = fmaf(q[i][2], k[2], a2); a3 = fmaf(q[i][3], k[3], a3); }
    return (a0 + a1) + (a2 + a3);
}
__device__ __forceinline__ v4u aent(float c, const float* p) { v4u e; e.x = __builtin_bit_cast(unsigned, c); e.y = 0u; const unsigned long long a = (unsigned long long)p; e.z = (unsigned)a; e.w = (unsigned)(a >> 32); return e; }
__device__ __forceinline__ void attn_item(int row, int h, int l, const float* Z, const float* ck, const float* cv, float* OA, LAS v4u* scr, int lane) {
    const bool samp = row >= MP;
    int b, pos;
    if (!samp) { b = row >> 12; pos = row & 4095; } else { const int r = row - MP; b = r >> 3; pos = 2048 + (r & 7); }
    float s0;
    {
        const float* qp = Z + (size_t)row * NIN + SEG_Q + h * 64;
        f32x4 q[16];
#pragma unroll
        for (int i = 0; i < 16; ++i) q[i] = *((const f32x4*)qp + i);
        s0 = dot64(q, kv_ptr(samp, b, pos, h, SEG_K, Z, ck, l));
#pragma unroll 1
        for (int ph = 0; ph < 6; ++ph) {
            const int d = 1 << (2 * (ph >> 1));
            const int j = 1 + (ph & 1) * 64 + lane; const int idx = pos - d * j; const bool valid = idx >= 0; const int ic = valid ? idx : pos;
            const float sdot = dot64(q, kv_ptr(samp, b, ic, h, SEG_K, Z, ck, l));
            scr[1 + ph * 64 + lane] = aent(valid ? sdot : -INFINITY, kv_ptr(samp, b, ic, h, SEG_V, Z, cv, l));
        }
    }
    const float* vself = kv_ptr(samp, b, pos, h, SEG_V, Z, cv, l);
    __builtin_amdgcn_wave_barrier(); LDS_WAIT();
    float sc[3][2], lse[3], e0[3], w[3];
#pragma unroll
    for (int p = 0; p < 3; ++p) {
        sc[p][0] = __builtin_bit_cast(float, scr[1 + p * 128 + lane].x); sc[p][1] = __builtin_bit_cast(float, scr[1 + p * 128 + 64 + lane].x);
        const float m = fmaxf(s0, wave_max(fmaxf(sc[p][0], sc[p][1])));
        sc[p][0] = __expf(sc[p][0] - m); sc[p][1] = __expf(sc[p][1] - m); e0[p] = __expf(s0 - m);
        const float lsum = e0[p] + wave_sum(sc[p][0] + sc[p][1]);
        lse[p] = m + __logf(lsum); w[p] = 1.f / lsum;
    }
    const float mx = fmaxf(lse[0], fmaxf(lse[1], lse[2]));
    const float x0 = __expf(lse[0] - mx), x1 = __expf(lse[1] - mx), x2 = __expf(lse[2] - mx);
    const float iw = 1.f / (x0 + x1 + x2);
    w[0] *= x0 * iw; w[1] *= x1 * iw; w[2] *= x2 * iw;
    const float cself = w[0] * e0[0] + w[1] * e0[1] + w[2] * e0[2];
#pragma unroll
    for (int p = 0; p < 3; ++p) { scr[1 + p * 128 + lane].x = __builtin_bit_cast(unsigned, w[p] * sc[p][0]); scr[1 + p * 128 + 64 + lane].x = __builtin_bit_cast(unsigned, w[p] * sc[p][1]); }
    if (lane < 4) scr[lane == 0 ? 0 : 384 + lane] = aent(lane == 0 ? cself : 0.f, vself);
    __builtin_amdgcn_wave_barrier(); LDS_WAIT();
    const int ks = lane >> 4, c4 = (lane & 15) * 4;
    f32x4 acc = {0.f, 0.f, 0.f, 0.f};
#pragma unroll 4
    for (int i = 0; i < 97; ++i) { const v4u e = scr[4 * i + ks]; const float* vp = (const float*)(((unsigned long long)e.w << 32) | e.z);
        const f32x4 v = *(const f32x4*)(vp + c4); acc = acc + v * __builtin_bit_cast(float, e.x); }
#pragma unroll
    for (int i = 0; i < 4; ++i) { acc[i] += __shfl_xor(acc[i], 16); acc[i] += __shfl_xor(acc[i], 32); }
    if (lane < 16) *(f32x4*)(OA + (size_t)row * 512 + h * 64 + c4) = acc;
    __builtin_amdgcn_wave_barrier(); LDS_WAIT();
}

#define XB_TMO      128
#define XB_XCNT(j)  (256  + 64 * (j))
#define XB_XSUB(j)  (1280 + 64 * (j))
#define XB_XGEN(j)  (2304 + 64 * (j))
#define XB_TOP      3328
#define XB_TOPGEN   3392
#define XCD_BAR_WORDS 3456
#define XB_SPIN_CAP (1u << 18)

__device__ __forceinline__ unsigned xb_ld(unsigned* p)              { return __hip_atomic_load(p, __ATOMIC_RELAXED, __HIP_MEMORY_SCOPE_AGENT); }
__device__ __forceinline__ unsigned xb_add(unsigned* p, unsigned v) { return __hip_atomic_fetch_add(p, v, __ATOMIC_RELAXED, __HIP_MEMORY_SCOPE_AGENT); }
__device__ __forceinline__ unsigned xb_xcc_id() { return (unsigned)__builtin_amdgcn_s_getreg((3 << 11) | 20) & 0xFu; }
#define XB_SPIN(cond, bar) do { unsigned _sp = 0; while (cond) { __builtin_amdgcn_s_sleep(1); \
    if ((++_sp & 255u) == 0u) { if (xb_ld(&(bar)[XB_TMO])) break; if (_sp > XB_SPIN_CAP) { atomicAdd(&(bar)[XB_TMO], 1u); break; } } } } while (0)

struct XcdBarrier {
    unsigned* bar; unsigned x;
    volatile LAS unsigned* st;
};

__device__ __forceinline__ XcdBarrier xcd_barrier_post(unsigned* bar, volatile LAS unsigned* st) {
    XcdBarrier b; b.bar = bar; b.x = xb_xcc_id(); b.st = st;
    if (threadIdx.x == 0) (void)xb_add(&bar[XB_XCNT(b.x)], 1u);
    return b;
}
__device__ __forceinline__ void xcd_barrier_complete(unsigned* bar, unsigned x, unsigned& nloc, unsigned& nx) {
    const unsigned G = gridDim.x * gridDim.y * gridDim.z;
    unsigned sum, cnt, mine, sp = 0u;
    for (;;) {
        sum = 0u; cnt = 0u; mine = 0u;
#pragma unroll
        for (unsigned j = 0; j < 16; ++j) { const unsigned c = xb_ld(&bar[XB_XCNT(j)]); sum += c; cnt += (c > 0u) ? 1u : 0u; mine = (j == x) ? c : mine; }
        if (sum == G) break;
        __builtin_amdgcn_s_sleep(1);
        if ((++sp & 255u) == 0u) { if (xb_ld(&bar[XB_TMO])) break; if (sp > XB_SPIN_CAP) { atomicAdd(&bar[XB_TMO], 1u); break; } }
    }
    nloc = mine > 0u ? mine : 1u; nx = cnt > 0u ? cnt : 1u;
}

__device__ __forceinline__ void xcd_barrier(const XcdBarrier& b) {
    asm volatile("s_waitcnt vmcnt(0)" ::: "memory");
    __syncthreads();
    if (threadIdx.x == 0) {
        unsigned* bar = b.bar;
        __builtin_amdgcn_s_waitcnt(0);
        unsigned nloc = b.st[0], nx = b.st[1];
        if (nloc == 0u) { xcd_barrier_complete(bar, b.x, nloc, nx); b.st[0] = nloc; b.st[1] = nx; }
        const unsigned old = xb_add(&bar[XB_XSUB(b.x)], 1u);
        const unsigned gen = old / nloc;
        if (old + 1u == (gen + 1u) * nloc) {
            __builtin_amdgcn_fence(__ATOMIC_RELEASE, "agent");
            asm volatile("s_waitcnt vmcnt(0)" ::: "memory");
            const unsigned og = xb_add(&bar[XB_TOP], 1u);
            const unsigned tg = og / nx;
            if (og + 1u == (tg + 1u) * nx) xb_add(&bar[XB_TOPGEN], 1u);
            else XB_SPIN(xb_ld(&bar[XB_TOPGEN]) == tg, bar);
            __builtin_amdgcn_fence(__ATOMIC_ACQUIRE, "agent");
            xb_add(&bar[XB_XGEN(b.x)], 1u);
            asm volatile("s_waitcnt vmcnt(0)" ::: "memory");
        } else {
            XB_SPIN(xb_ld(&bar[XB_XGEN(b.x)]) == gen, bar);
            __builtin_amdgcn_fence(__ATOMIC_ACQUIRE, "agent");
            asm volatile("s_waitcnt vmcnt(0)" ::: "memory");
        }
    }
    __syncthreads();
}

struct Args { const float* in[22]; float* out; unsigned char* ws; int ph_lo, ph_hi; };
constexpr int N_PHASES = 23;

__global__ void __launch_bounds__(NWAVES * 64, 2) mk_fwd(Args args) {
    extern __shared__ __attribute__((aligned(16))) unsigned char lds_raw[];
    LAS unsigned char* lds = (LAS unsigned char*)lds_raw;
    const int G = gridDim.x, bx = blockIdx.x, NGW = G * NWAVES;
#define FRESH() int tid_ = threadIdx.x; asm volatile("" : "+v"(tid_)); const int tid = tid_, lane = tid & 63, wave = __builtin_amdgcn_readfirstlane(tid >> 6), gw = bx * NWAVES + wave; (void)tid; (void)lane; (void)gw;
    unsigned char* ws = args.ws;
    float* LB = (float*)(ws + WS_LB);
    bf16* Wb = (bf16*)(ws + WS_W);
    bf16* XN = (bf16*)(ws + WS_XN); bf16* OB = (bf16*)(ws + WS_O); bf16* HID = (bf16*)(ws + WS_HID);
    float* Y = (float*)(ws + WS_Y); float* HR = (float*)(ws + WS_H); float* Z = (float*)(ws + WS_Z);
    float* OA = (float*)(ws + WS_OA); float* OH = (float*)(ws + WS_OH);
    bf16* QB = (bf16*)(ws + WS_QB); bf16* OPB = (bf16*)(ws + WS_OP); float* LSE = (float*)(ws + WS_LSE);
    float* out = args.out;
    const int lo = args.ph_lo, hi = args.ph_hi;
#define IN(k) (lo <= (k) && (k) < hi)
#define SEAM(k) do { if (IN(k) && IN((k) + 1)) { if ((k) == 0) cg::this_grid().sync(); else xcd_barrier(xbar); } } while (0)
    volatile LAS unsigned* MISC = (volatile LAS unsigned*)(lds + 131072 + 64);
    if (threadIdx.x < 2) MISC[threadIdx.x] = 0u;
    __syncthreads();
    XcdBarrier xbar = xcd_barrier_post((unsigned*)(ws + WS_BAR), MISC);

    if (IN(0)) {
        FRESH();
        LAS float* scr = (LAS float*)(lds + wave * 16384);
        constexpr int I_FF = (D / 64) * (FF / 32), I_DN = (FF / 64) * (D / 32), I_IN = (D / 64) * (NIN / 32), I_OUT = (D / 64) * (D / 32);
        constexpr int I_LAYER = 4 * I_FF + 2 * I_DN + I_IN + I_OUT;
        for (int it = gw; it < 2 * I_LAYER; it += NGW) {
            const int l = it / I_LAYER; int r = it % I_LAYER;
            bf16* wl = Wb + (size_t)l * W_LAYER;
            if (r < I_FF) { p0_transpose_item(args.in[6] + (size_t)l * D * FF, D, FF, wl + W_G1, 1, scr, r, lane); continue; } r -= I_FF;
            if (r < I_FF) { p0_transpose_item(args.in[7] + (size_t)l * D * FF, D, FF, wl + W_G1, 2, scr, r, lane); continue; } r -= I_FF;
            if (r < I_DN) { p0_transpose_item(args.in[8] + (size_t)l * D * FF, FF, D, wl + W_D1, 0, scr, r, lane); continue; } r -= I_DN;
            if (r < I_IN) { p0_transpose_item(args.in[11] + (size_t)l * D * NIN, D, NIN, wl + W_IN, 0, scr, r, lane); continue; } r -= I_IN;
            if (r < I_OUT) { p0_transpose_item(args.in[15] + (size_t)l * D * D, D, D, wl + W_OUT, 0, scr, r, lane); continue; } r -= I_OUT;
            if (r < I_FF) { p0_transpose_item(args.in[18] + (size_t)l * D * FF, D, FF, wl + W_G2, 1, scr, r, lane); continue; } r -= I_FF;
            if (r < I_FF) { p0_transpose_item(args.in[19] + (size_t)l * D * FF, D, FF, wl + W_G2, 2, scr, r, lane); continue; } r -= I_FF;
            p0_transpose_item(args.in[20] + (size_t)l * D * FF, FF, D, wl + W_D2, 0, scr, r, lane);
        }
        if (bx == 0) {
            const float* lg = args.in[13];
            const float x0 = lg[tid], x1 = lg[512 + tid];
            LB[tid] = 0.f; LB[512 + tid] = 1.f / (1.f + __expf(x0 - x1));
        }
        row_phase<false>(args.in[0], args.in[1], nullptr, nullptr, 0.f, nullptr, args.in[5], XN, gw, NGW, lane);
    }
    SEAM(0);

#pragma unroll 1
    for (int l = 0; l < 2; ++l) {
        const int pb = 1 + 11 * l;
        const bf16* wl = Wb + (size_t)l * W_LAYER;
        if (IN(pb + 0)) {
            pg8::Gemm g{XN, wl + W_G1, M, 2 * FF, D}; pg8::StaticOrder S; S.init(M, 2 * FF, G, bx);
            EpiSwiglu E{HID};
            pg8::gemm_phase<EpiSwiglu, pg8::StaticOrder, true, true>(lds, g, S, E);
        }
        SEAM(pb + 0);
        if (IN(pb + 1)) {
            pg8::Gemm g{HID, wl + W_D1, M, D, FF}; pg8::StaticOrder S; S.init(M, D, G, bx);
            EpiF32 E{Y, D};
            pg8::gemm_phase<EpiF32, pg8::StaticOrder, true, true>(lds, g, S, E);
        }
        SEAM(pb + 1);
        if (IN(pb + 2)) {
            FRESH();
            if (l == 0) row_phase<true>(args.in[0], args.in[1], Y, args.in[9] + l * D, 0.5f, HR, args.in[10] + l * D, XN, gw, NGW, lane);
            else        row_phase<true>(HR, nullptr, Y, args.in[9] + l * D, 0.5f, HR, args.in[10] + l * D, XN, gw, NGW, lane);
        }
        SEAM(pb + 2);
        if (IN(pb + 3)) {
            pg8::Gemm g{XN, wl + W_IN, M, NIN, D}; pg8::StaticOrder S; S.init(M, NIN, G, bx);
            EpiMix E{Z, LB + l * 512, out, l, QB};
            pg8::gemm_phase<EpiMix, pg8::StaticOrder, true, true>(lds, g, S, E);
        }
        SEAM(pb + 3);
        if (IN(pb + 4)) {
            FRESH();
            if (wave < 4) {
                LAS float* scr = (LAS float*)(lds + wave * 16384);
                const int hw = bx * 4 + wave, NHW = G * 4;
                for (int task = hw; task < 1024; task += NHW) {
                    const int seq = task >> 6, vg = task & 63, b = seq >> 2, h = seq & 3;
                    hgrn_task<32>(Z, OH, nullptr, out + OFF_SP + ((size_t)(l * 4 + b) * 4 + h) * 16384, b * SEQ, SEQ, h, vg, scr, lane);
                }
                for (int task = hw; task < 8192; task += NHW) {
                    const int b = task >> 8, h = (task >> 6) & 3, vg = task & 63;
                    const size_t so = ((size_t)(l * 32 + b) * 4 + h) * 16384;
                    hgrn_task<8>(Z, OH, args.in[4] + so, out + OFF_SS + so, MP + b * 8, 8, h, vg, scr, lane);
                }
            } else {
                const int aw = bx * 4 + (wave - 4), NAW = G * 4;
                {
                    LAS unsigned char* vimg = lds + wave * 16384;
                    constexpr int NU = 4 * 3 * 128 * 8;
                    const int per = (NU + NAW - 1) / NAW, u0 = aw * per, u1 = (u0 + per < NU) ? u0 + per : NU;
                    for (int u = u0; u < u1; ++u) attn_unit(u, QB, QB + (size_t)MP * 512, QB + (size_t)2 * MP * 512, OPB, LSE, vimg, lane);
                }
                LAS v4u* scr = (LAS v4u*)(lds + wave * 16384);
                for (int it = MP * 8 + aw; it < M * 8; it += NAW) attn_item(it >> 3, it & 7, l, Z, args.in[2], args.in[3], OA, scr, lane);
            }
        }
        SEAM(pb + 4);
        if (IN(pb + 5)) { FRESH(); r3_phase(OA, OPB, LSE, OH, Z, args.in[12] + l * 512, args.in[14] + l * 128, OB, gw, NGW, lane); }
        SEAM(pb + 5);
        if (IN(pb + 6)) {
            pg8::Gemm g{OB, wl + W_OUT, M, D, D}; pg8::StaticOrder S; S.init(M, D, G, bx);
            EpiF32 E{Y, D};
            pg8::gemm_phase<EpiF32, pg8::StaticOrder, true, true>(lds, g, S, E);
        }
        SEAM(pb + 6);
        if (IN(pb + 7)) { FRESH(); row_phase<true>(HR, nullptr, Y, args.in[16] + l * D, 1.0f, HR, args.in[17] + l * D, XN, gw, NGW, lane); }
        SEAM(pb + 7);
        if (IN(pb + 8)) {
            pg8::Gemm g{XN, wl + W_G2, M, 2 * FF, D}; pg8::StaticOrder S; S.init(M, 2 * FF, G, bx);
            EpiSwiglu E{HID};
            pg8::gemm_phase<EpiSwiglu, pg8::StaticOrder, true, true>(lds, g, S, E);
        }
        SEAM(pb + 8);
        if (IN(pb + 9)) {
            pg8::Gemm g{HID, wl + W_D2, M, D, FF}; pg8::StaticOrder S; S.init(M, D, G, bx);
            EpiF32 E{Y, D};
            pg8::gemm_phase<EpiF32, pg8::StaticOrder, true, true>(lds, g, S, E);
        }
        SEAM(pb + 9);
        if (IN(pb + 10)) {
            FRESH();
            if (l == 0) row_phase<true>(HR, nullptr, Y, args.in[21] + l * D, 0.5f, HR, args.in[5] + D, XN, gw, NGW, lane);
            else        row_phase<true>(HR, nullptr, Y, args.in[21] + l * D, 0.5f, out + OFF_Y, nullptr, nullptr, gw, NGW, lane);
        }
        SEAM(pb + 10);
    }
#undef IN
#undef SEAM
}

extern "C" void kernel_launch(void* const* d_in, const int* in_sizes, int n_in, void* d_out, int out_size, void* d_ws, size_t ws_size, hipStream_t stream) {
    static int grid = 0;
    if (grid == 0) {
        if (n_in != 22 || ws_size < WS_END) { fprintf(stderr, "kernel_launch: n_in %d ws %zu (need %zu)\n", n_in, ws_size, (size_t)WS_END); grid = -1; return; }
        int dev = 0, cus = 0, per_cu = 0;
        (void)hipGetDevice(&dev);
        (void)hipDeviceGetAttribute(&cus, hipDeviceAttributeMultiprocessorCount, dev);
        if (hipFuncSetAttribute((const void*)mk_fwd, hipFuncAttributeMaxDynamicSharedMemorySize, LDS_BYTES) != hipSuccess) { fprintf(stderr, "kernel_launch: hipFuncSetAttribute failed\n"); grid = -1; return; }
        if (hipOccupancyMaxActiveBlocksPerMultiprocessor(&per_cu, (const void*)mk_fwd, NWAVES * 64, LDS_BYTES) != hipSuccess || per_cu < 1) { fprintf(stderr, "kernel_launch: occupancy query says %d\n", per_cu); per_cu = 1; }
        (void)hipGetLastError();
        grid = cus * (per_cu > 1 ? 1 : per_cu);
        fprintf(stderr, "kernel_launch: grid %d (cus %d per_cu %d)\n", grid, cus, per_cu);
    }
    if (grid < 0) return;
    if (hipMemsetAsync((char*)d_ws + WS_BAR, 0, 16384, stream) != hipSuccess) { fprintf(stderr, "kernel_launch: memset failed\n"); return; }
    Args a{};
    for (int i = 0; i < 22; ++i) a.in[i] = (const float*)d_in[i];
    a.out = (float*)d_out; a.ws = (unsigned char*)d_ws;
#if MK_MULTI
    for (int p = 0; p < N_PHASES; ++p) {
        a.ph_lo = p; a.ph_hi = p + 1;
        void* kargs[] = {&a};
        hipError_t e = hipLaunchCooperativeKernel((const void*)mk_fwd, dim3(grid), dim3(NWAVES * 64), kargs, LDS_BYTES, stream);
        if (e != hipSuccess) { fprintf(stderr, "kernel_launch: launch %d failed: %s\n", p, hipGetErrorString(e)); break; }
    }
#else
    a.ph_lo = 0; a.ph_hi = N_PHASES;
    void* kargs[] = {&a};
    hipError_t e = hipLaunchCooperativeKernel((const void*)mk_fwd, dim3(grid), dim3(NWAVES * 64), kargs, LDS_BYTES, stream);
    if (e != hipSuccess) fprintf(stderr, "kernel_launch: cooperative launch failed: %s (grid %d)\n", hipGetErrorString(e), grid);
#endif
}
```

```cpp
#include <hip/hip_runtime.h>
#include <hip/hip_cooperative_groups.h>
#include <cstdio>
#include <cstdint>
namespace cg = cooperative_groups;

#ifndef MK_MULTI
#define MK_MULTI 0
#endif

namespace pg8 {
#define PG8_LAS __attribute__((address_space(3)))
typedef unsigned short bf16_t;
typedef short bf16x8 __attribute__((ext_vector_type(8)));
typedef float f32x4 __attribute__((ext_vector_type(4)));
typedef unsigned u32x4 __attribute__((ext_vector_type(4)));
constexpr int BM = 256, BK = 64, HALF = 128, HTB = HALF * BK * 2  , STAGE_BYTES = 8 * HTB, NXCD = 8, WGM = 8;

__host__ __device__ __forceinline__ int lds_byte(int r, int c) { const int st = (r >> 4) * 2 + (c >> 5), rr = r & 15, cc = c & 31, ob = rr * 64 + cc * 2; return st * 1024 + (ob ^ (((ob >> 9) & 1) << 5)); }
__host__ __device__ __forceinline__ void stage_rc(int b, int& R, int& C) { const int st = b / 1024, sb = b % 1024, swz = sb ^ (((sb >> 9) & 1) << 5); R = (st >> 1) * 16 + swz / 64; C = (st & 1) * 32 + (swz % 64) / 2; }
__host__ __device__ __forceinline__ int perm32(int rho) { const int n = rho >> 4, i = rho & 15; return 8 * (i >> 2) + 4 * n + (i & 3); }

struct Unit { int pm, pn; };
struct Gemm { const bf16_t* A; const bf16_t* Bt; int M, N, K; };

struct StaticOrder {
    int nM, nN, nwg, G, c;
    __host__ __device__ void init(int M, int N, int G_, int c_) { nM = M / BM; nN = N / BM; nwg = nM * nN; G = G_; c = c_; }
    __host__ __device__ bool next(int i, Unit& u) const {
        const long L = (long)i * G + c; if (L >= nwg) return false;
        int wgid = (int)L; { const int q = nwg / NXCD, r = nwg % NXCD, xcd = wgid % NXCD, off = wgid / NXCD; wgid = (xcd < r ? xcd * (q + 1) : r * (q + 1) + (xcd - r) * q) + off; }
        const int nig = WGM * nN, gid = wgid / nig, fm = gid * WGM, gsz = (nM - fm) < WGM ? (nM - fm) : WGM;
        u.pm = fm + ((wgid % nig) % gsz); u.pn = (wgid % nig) / gsz; return true;
    }
    __device__ __forceinline__ void a_ready(const Unit&) const {}
    __device__ __forceinline__ void done(const Unit&) const {}
};

template <class Epi, class Sched, bool ALIGN_EPI = false, bool SP2 = false>
__device__ __forceinline__ void gemm_phase(PG8_LAS unsigned char* lds, const Gemm g, const Sched& S, const Epi& E) {
    int tid_ = threadIdx.x; asm volatile("" : "+v"(tid_));
    const int tid = tid_, wid = __builtin_amdgcn_readfirstlane(tid >> 6), lane = tid & 63, wr = wid >> 2, wc = wid & 3, fr = lane & 15, fq = lane >> 4;
    const int K = g.K, nt = K / BK;
    unsigned voffA[2], voffB[2];
#pragma unroll
    for (int i = 0; i < 2; ++i) { int R, C; stage_rc(tid * 16 + i * 8192, R, C); const int Rb = Epi::PERM ? ((R & ~31) + perm32(R & 31)) : R;
        voffA[i] = (unsigned)(R * K + C) * 2u; voffB[i] = (unsigned)(Rb * K + C) * 2u; }
    const size_t kstep = (size_t)(BK * 2);
    const size_t hstep = (size_t)HALF * K * 2;
    const size_t tstep = 2 * hstep;
    const unsigned ldsw = (unsigned)wid * 1024u;
    const int aoff = lds_byte(wr * 64 + fr, fq * 8), boff = lds_byte(wc * 32 + fr, fq * 8);
#define PG8_SA(b, h) (((b) * 2 + (h)) * HTB)
#define PG8_SB(b, h) ((4 + (b) * 2 + (h)) * HTB)
#define PG8_STAGE(bufoff, gbase, voff) do { _Pragma("unroll") for (int _i = 0; _i < 2; ++_i) \
        __builtin_amdgcn_global_load_lds((const unsigned*)((const char*)(gbase) + (voff)[_i]), (PG8_LAS unsigned*)(lds + (bufoff) + ldsw + _i * 8192), 16, 0, 0); } while (0)
#define PG8_LDA(dst, b, h) do { _Pragma("unroll") for (int m = 0; m < 4; ++m) _Pragma("unroll") for (int k = 0; k < 2; ++k) dst[m][k] = *(const PG8_LAS bf16x8*)(lds + PG8_SA(b, h) + aoff + m * 2048 + k * 1024); } while (0)
#define PG8_LDB(dst, b, h) do { _Pragma("unroll") for (int n = 0; n < 2; ++n) _Pragma("unroll") for (int k = 0; k < 2; ++k) dst[n][k] = *(const PG8_LAS bf16x8*)(lds + PG8_SB(b, h) + boff + n * 2048 + k * 1024); } while (0)
#define PG8_MMA(ai, bj, At, Bt) do { __builtin_amdgcn_s_setprio(1); _Pragma("unroll") for (int m = 0; m < 4; ++m) _Pragma("unroll") for (int n = 0; n < 2; ++n) _Pragma("unroll") for (int k = 0; k < 2; ++k) \
        acc[ai][bj][m][n] = __builtin_amdgcn_mfma_f32_16x16x32_bf16(Bt[n][k], At[m][k], acc[ai][bj][m][n], 0, 0, 0); __builtin_amdgcn_s_setprio(0); } while (0)
#define PG8_WAIT_V(n) asm volatile("s_waitcnt vmcnt(" #n ")" ::: "memory")
#define PG8_WAIT_L(n) asm volatile("s_waitcnt lgkmcnt(" #n ")" ::: "memory")
#define PG8_BAR __builtin_amdgcn_s_barrier()
#define PG8_SCHED __builtin_amdgcn_sched_barrier(0)
    Unit cur, nxt; int ui = 0;
    if (!S.next(0, cur)) return;
    f32x4 acc[2][2][4][2];
#pragma unroll
    for (int a = 0; a < 2; ++a)
#pragma unroll
        for (int b = 0; b < 2; ++b)
#pragma unroll
            for (int m = 0; m < 4; ++m)
#pragma unroll
                for (int n = 0; n < 2; ++n) acc[a][b][m][n] = (f32x4){0.f, 0.f, 0.f, 0.f};
    bf16x8 At[4][2], B0[2][2], B1[2][2];
    const char* cA = (const char*)g.A + (size_t)cur.pm * tstep; const char* cB = (const char*)g.Bt + (size_t)cur.pn * tstep;
    S.a_ready(cur);
    if constexpr (SP2) {
        PG8_STAGE(PG8_SB(0, 0), cB, voffB); PG8_STAGE(PG8_SB(0, 1), cB + hstep, voffB); PG8_STAGE(PG8_SA(0, 0), cA, voffA); PG8_STAGE(PG8_SA(0, 1), cA + hstep, voffA);
        if (wr == 1) PG8_BAR;
        PG8_WAIT_V(2); PG8_BAR;
        PG8_STAGE(PG8_SB(1, 0), cB + kstep, voffB); PG8_STAGE(PG8_SA(1, 0), cA + kstep, voffA); PG8_STAGE(PG8_SB(1, 1), cB + hstep + kstep, voffB);
        PG8_WAIT_V(6); PG8_BAR;
    } else {
        PG8_STAGE(PG8_SB(0, 0), cB, voffB); PG8_STAGE(PG8_SA(0, 0), cA, voffA); PG8_STAGE(PG8_SB(0, 1), cB + hstep, voffB); PG8_STAGE(PG8_SA(0, 1), cA + hstep, voffA);
        if (wr == 1) PG8_BAR;
        PG8_WAIT_V(4); PG8_BAR;
        PG8_STAGE(PG8_SB(1, 0), cB + kstep, voffB); PG8_STAGE(PG8_SA(1, 0), cA + kstep, voffA); PG8_STAGE(PG8_SB(1, 1), cB + hstep + kstep, voffB);
        PG8_WAIT_V(6); PG8_BAR;
    }
    for (;;) {
        const bool has_next = S.next(ui + 1, nxt);
        const char* nA = has_next ? (const char*)g.A + (size_t)nxt.pm * tstep : cA; const char* nB = has_next ? (const char*)g.Bt + (size_t)nxt.pn * tstep : cB;
        for (int t = 0; t < nt; t += 2) {
            const bool last = (t == nt - 2);
            const char* a1 = cA + (size_t)(t + 1) * kstep;
            const char* a2 = last ? nA : cA + (size_t)(t + 2) * kstep; const char* b2 = last ? nB : cB + (size_t)(t + 2) * kstep;
            const char* a3 = a2 + kstep; const char* b3 = b2 + kstep;
            if (last && has_next) S.a_ready(nxt);
            if constexpr (SP2) {
            PG8_LDB(B0, 0, 0); PG8_LDB(B1, 0, 1); PG8_SCHED; PG8_LDA(At, 0, 0); PG8_STAGE(PG8_SA(1, 1), a1 + hstep, voffA);
            PG8_WAIT_V(8); PG8_WAIT_L(0); PG8_BAR; PG8_MMA(0, 0, At, B0); PG8_MMA(0, 1, At, B1); PG8_BAR; PG8_SCHED;
            PG8_LDA(At, 0, 1); PG8_STAGE(PG8_SB(0, 0), b2, voffB); PG8_STAGE(PG8_SB(0, 1), b2 + hstep, voffB); PG8_STAGE(PG8_SA(0, 0), a2, voffA);
            PG8_WAIT_V(8); PG8_WAIT_L(0); PG8_BAR; PG8_MMA(1, 0, At, B0); PG8_MMA(1, 1, At, B1); PG8_BAR; PG8_SCHED;
            PG8_LDB(B0, 1, 0); PG8_LDB(B1, 1, 1); PG8_SCHED; PG8_LDA(At, 1, 0); PG8_STAGE(PG8_SA(0, 1), a2 + hstep, voffA);
            PG8_WAIT_V(8); PG8_WAIT_L(0); PG8_BAR; PG8_MMA(0, 0, At, B0); PG8_MMA(0, 1, At, B1); PG8_BAR; PG8_SCHED;
            PG8_LDA(At, 1, 1); PG8_STAGE(PG8_SB(1, 0), b3, voffB); PG8_STAGE(PG8_SB(1, 1), b3 + hstep, voffB); PG8_STAGE(PG8_SA(1, 0), a3, voffA);
            PG8_WAIT_V(8); PG8_WAIT_L(0); PG8_BAR; PG8_MMA(1, 0, At, B0); PG8_MMA(1, 1, At, B1); PG8_BAR; PG8_SCHED;
            } else {
            PG8_LDB(B0, 0, 0); PG8_SCHED; PG8_LDA(At, 0, 0); PG8_STAGE(PG8_SA(1, 1), a1 + hstep, voffA);
            PG8_WAIT_L(8); PG8_BAR; PG8_WAIT_L(0); PG8_MMA(0, 0, At, B0); PG8_BAR; PG8_SCHED;
            PG8_LDB(B1, 0, 1); PG8_STAGE(PG8_SB(0, 0), b2, voffB);
            PG8_BAR; PG8_WAIT_L(0); PG8_MMA(0, 1, At, B1); PG8_BAR;
            PG8_LDA(At, 0, 1); PG8_STAGE(PG8_SA(0, 0), a2, voffA);
            PG8_BAR; PG8_WAIT_L(0); PG8_MMA(1, 0, At, B0); PG8_BAR; PG8_SCHED;
            PG8_STAGE(PG8_SB(0, 1), b2 + hstep, voffB);
            PG8_WAIT_V(6); PG8_BAR; PG8_MMA(1, 1, At, B1); PG8_BAR;
            PG8_LDB(B0, 1, 0); PG8_SCHED; PG8_LDA(At, 1, 0); PG8_STAGE(PG8_SA(0, 1), a2 + hstep, voffA);
            PG8_WAIT_L(8); PG8_BAR; PG8_WAIT_L(0); PG8_MMA(0, 0, At, B0); PG8_BAR; PG8_SCHED;
            PG8_LDB(B1, 1, 1); PG8_STAGE(PG8_SB(1, 0), b3, voffB);
            PG8_BAR; PG8_WAIT_L(0); PG8_MMA(0, 1, At, B1); PG8_BAR;
            PG8_LDA(At, 1, 1); PG8_STAGE(PG8_SA(1, 0), a3, voffA);
            PG8_BAR; PG8_WAIT_L(0); PG8_MMA(1, 0, At, B0); PG8_BAR; PG8_SCHED;
            PG8_STAGE(PG8_SB(1, 1), b3 + hstep, voffB);
            PG8_WAIT_V(6); PG8_BAR; PG8_MMA(1, 1, At, B1); PG8_BAR;
            }
        }
        if constexpr (ALIGN_EPI) { if (wr == 0) PG8_BAR; }
        if constexpr (!Epi::AFTER_DRAIN) { E(acc, cur, wr, wc, fr, fq); S.done(cur); }
        if (!has_next) break;
#pragma unroll
        for (int a = 0; a < 2; ++a)
#pragma unroll
            for (int b = 0; b < 2; ++b)
#pragma unroll
                for (int m = 0; m < 4; ++m)
#pragma unroll
                    for (int n = 0; n < 2; ++n) acc[a][b][m][n] = (f32x4){0.f, 0.f, 0.f, 0.f};
        cur = nxt; cA = nA; cB = nB; ++ui;
        if constexpr (ALIGN_EPI) { if (wr == 1) PG8_BAR; }
    }
    PG8_WAIT_V(0);
    if constexpr (!ALIGN_EPI) { if (wr == 0) PG8_BAR; }
    PG8_BAR;
    if constexpr (Epi::AFTER_DRAIN) { E.fused(acc, cur, wr, wc, fr, fq, lds, wid, lane); S.done(cur); }
#undef PG8_SA
#undef PG8_SB
#undef PG8_STAGE
#undef PG8_LDA
#undef PG8_LDB
#undef PG8_MMA
#undef PG8_WAIT_V
#undef PG8_WAIT_L
#undef PG8_BAR
#undef PG8_SCHED
}
}

constexpr int NWAVES = 8;
constexpr int D = 1024, FF = 2816, NIN = 3584, MP = 16384, MS = 256, M = MP + MS, SEQ = 4096;
constexpr int SEG_Q = 0, SEG_K = 512, SEG_V = 1024, SEG_BQ = 1536, SEG_BF = 2048, SEG_BI = 2560, SEG_BG = 3072;
constexpr float EPS = 1e-6f;
constexpr size_t OFF_Y = 0, OFF_KP = 17039360, OFF_VP = 25427968, OFF_SP = 33816576, OFF_KS = 34340864, OFF_VS = 34603008, OFF_SS = 34865152;
constexpr size_t MiB = 1u << 20;
constexpr size_t WS_LB = 0;
constexpr size_t WS_BAR = 65536;
constexpr size_t WS_W = 1 * MiB;
constexpr size_t W_G1 = 0, W_D1 = W_G1 + (size_t)2 * FF * D, W_IN = W_D1 + (size_t)D * FF, W_OUT = W_IN + (size_t)NIN * D,
                 W_G2 = W_OUT + (size_t)D * D, W_D2 = W_G2 + (size_t)2 * FF * D, W_LAYER = W_D2 + (size_t)D * FF;
constexpr size_t WS_XN = WS_W + 2 * W_LAYER * 2;
constexpr size_t WS_O = WS_XN + (size_t)M * D * 2;
constexpr size_t WS_HID = WS_O + (size_t)M * D * 2;
constexpr size_t WS_Y = WS_HID + (size_t)M * FF * 2;
constexpr size_t WS_H = WS_Y + (size_t)M * D * 4;
constexpr size_t WS_Z = WS_H + (size_t)M * D * 4;
constexpr size_t WS_OA = WS_Z + (size_t)M * NIN * 4;
constexpr size_t WS_OH = WS_OA + (size_t)M * 512 * 4;
constexpr size_t WS_QB = WS_OH + (size_t)M * 512 * 4;
constexpr size_t WS_KB = WS_QB + (size_t)MP * 512 * 2;
constexpr size_t WS_VB = WS_KB + (size_t)MP * 512 * 2;
constexpr size_t WS_OP = WS_VB + (size_t)MP * 512 * 2;
constexpr size_t WS_LSE = WS_OP + (size_t)3 * M * 512 * 2;
constexpr size_t WS_U = WS_LSE + (size_t)3 * M * 8 * 4;
constexpr size_t WS_DEC = WS_U + (size_t)1024 * 16384 * 4;
constexpr size_t WS_SPREV = WS_DEC + (size_t)1024 * 128 * 4;
constexpr size_t WS_END = WS_SPREV + (size_t)1024 * 16384 * 2;
constexpr int LDS_BYTES = 147456 + 256, LDS_MISC = 147456, WLDS = 18432;

#define GAS __attribute__((address_space(1)))
#define LAS __attribute__((address_space(3)))
typedef unsigned short bf16;
typedef unsigned v4u __attribute__((ext_vector_type(4)));
typedef float f32x4 __attribute__((ext_vector_type(4)));
#define LDS_WAIT() asm volatile("s_waitcnt lgkmcnt(0)" ::: "memory")

__device__ __forceinline__ unsigned f2bf(float f) { unsigned u = __builtin_bit_cast(unsigned, f); return (u + 0x7fffu + ((u >> 16) & 1u)) >> 16; }
__device__ __forceinline__ unsigned pk2(float lo, float hi) { return f2bf(lo) | (f2bf(hi) << 16); }
__device__ __forceinline__ float silu_f(float x) { return x * __frcp_rn(1.f + __expf(-x)); }
__device__ __forceinline__ float sigmoid_f(float x) { return __frcp_rn(1.f + __expf(-x)); }
__device__ __forceinline__ float wave_sum(float v) {
#pragma unroll
    for (int o = 1; o < 64; o <<= 1) v += __shfl_xor(v, o);
    return v;
}
__device__ __forceinline__ float wave_max(float v) {
#pragma unroll
    for (int o = 1; o < 64; o <<= 1) v = fmaxf(v, __shfl_xor(v, o));
    return v;
}

struct EpiSwiglu {
    static constexpr bool PERM = true, AFTER_DRAIN = false;
    bf16* H;
    __device__ __forceinline__ void operator()(const pg8::f32x4 (&acc)[2][2][4][2], const pg8::Unit& u, int wr, int wc, int fr, int fq) const {
        const int row0 = u.pm * 256 + wr * 64 + fr, col0 = u.pn * 128 + wc * 32 + 8 * fq;
#pragma unroll
        for (int ai = 0; ai < 2; ++ai)
#pragma unroll
            for (int m = 0; m < 4; ++m) {
                bf16* rowp = H + (size_t)(row0 + ai * 128 + m * 16) * FF + col0;
                const pg8::f32x4 g0 = acc[ai][0][m][0], g1 = acc[ai][0][m][1], u0 = acc[ai][1][m][0], u1 = acc[ai][1][m][1];
                v4u w;
                w.x = pk2(silu_f(g0[0]) * u0[0], silu_f(g0[1]) * u0[1]); w.y = pk2(silu_f(g0[2]) * u0[2], silu_f(g0[3]) * u0[3]);
                w.z = pk2(silu_f(g1[0]) * u1[0], silu_f(g1[1]) * u1[1]); w.w = pk2(silu_f(g1[2]) * u1[2], silu_f(g1[3]) * u1[3]);
                *(v4u*)rowp = w;
            }
    }
};
struct EpiF32 {
    static constexpr bool PERM = true, AFTER_DRAIN = false;
    float* Y; int ldc;
    __device__ __forceinline__ void operator()(const pg8::f32x4 (&acc)[2][2][4][2], const pg8::Unit& u, int wr, int wc, int fr, int fq) const {
        const int row0 = u.pm * 256 + wr * 64 + fr, col0 = u.pn * 256 + wc * 32 + 8 * fq;
#pragma unroll
        for (int ai = 0; ai < 2; ++ai)
#pragma unroll
            for (int m = 0; m < 4; ++m) {
                float* rowp = Y + (size_t)(row0 + ai * 128 + m * 16) * ldc + col0;
#pragma unroll
                for (int bj = 0; bj < 2; ++bj)
#pragma unroll
                    for (int n = 0; n < 2; ++n) *(f32x4*)(rowp + bj * 128 + 4 * n) = acc[ai][bj][m][n];
            }
    }
};
struct EpiMix {
    static constexpr bool PERM = true, AFTER_DRAIN = false;
    float* Z; const float* lb; float* out; int l; bf16* QKV;
    __device__ __forceinline__ void operator()(const pg8::f32x4 (&acc)[2][2][4][2], const pg8::Unit& u, int wr, int wc, int fr, int fq) const {
        const int seg = u.pn >> 1;
        const int row0 = u.pm * 256 + wr * 64 + fr, cs0 = (u.pn & 1) * 256 + wc * 32 + 8 * fq;
        f32x4 lbv[2][2];
#pragma unroll
        for (int bj = 0; bj < 2; ++bj)
#pragma unroll
            for (int n = 0; n < 2; ++n) lbv[bj][n] = (seg == 4) ? *(const f32x4*)(lb + cs0 + bj * 128 + 4 * n) : (f32x4){0.f, 0.f, 0.f, 0.f};
#pragma unroll
        for (int ai = 0; ai < 2; ++ai)
#pragma unroll
            for (int m = 0; m < 4; ++m) {
                const int row = row0 + ai * 128 + m * 16;
                float* zrow = Z + (size_t)row * NIN + seg * 512 + cs0;
                float* orow = nullptr;
                f32x4 vv[2][2];
                if (seg == 1 || seg == 2) {
                    if (row < MP) { const int b = row >> 12, t = row & 4095;
                        if (t >= 2048) orow = out + (seg == 1 ? OFF_KP : OFF_VP) + ((size_t)(l * 4 + b) * 2048 + (t - 2048)) * 512 + cs0; }
                    else orow = out + (seg == 1 ? OFF_KS : OFF_VS) + ((size_t)l * 256 + (row - MP)) * 512 + cs0;
                }
#pragma unroll
                for (int bj = 0; bj < 2; ++bj)
#pragma unroll
                    for (int n = 0; n < 2; ++n) {
                        f32x4 v = acc[ai][bj][m][n];
                        if (seg == 0) v = v * 0.125f;
                        else if (seg == 3 || seg == 6) { v[0] = silu_f(v[0]); v[1] = silu_f(v[1]); v[2] = silu_f(v[2]); v[3] = silu_f(v[3]); }
                        else if (seg == 4) {
                            const f32x4 b4 = lbv[bj][n];
#pragma unroll
                            for (int i = 0; i < 4; ++i) v[i] = b4[i] + (1.f - b4[i]) * sigmoid_f(v[i]);
                        }
                        if (!(seg < 3 && row < MP)) *(f32x4*)(zrow + bj * 128 + 4 * n) = v;
                        if (orow) *(f32x4*)(orow + bj * 128 + 4 * n) = v;
                        vv[bj][n] = v;
                    }
                if (seg < 3 && row < MP) {
                    bf16* qrow = QKV + (size_t)seg * MP * 512 + (size_t)row * 512 + cs0;
#pragma unroll
                    for (int bj = 0; bj < 2; ++bj) { v4u w; w.x = pk2(vv[bj][0][0], vv[bj][0][1]); w.y = pk2(vv[bj][0][2], vv[bj][0][3]); w.z = pk2(vv[bj][1][0], vv[bj][1][1]); w.w = pk2(vv[bj][1][2], vv[bj][1][3]);
                        *(v4u*)(qrow + bj * 128) = w; }
                }
            }
    }
};

__device__ __forceinline__ void p0_transpose_item(const float* W, int K, int N, bf16* WT, int mode, LAS float* scr, int item, int lane) {
    const int nblk = N / 32, kb = item / nblk, nb = item % nblk, k0 = 64 * kb, n0 = 32 * nb;
    const int r0 = (mode == 0) ? n0 : ((n0 >> 7) * 256 + (mode - 1) * 128 + (n0 & 127));
#pragma unroll 8
    for (int i = 0; i < 32; ++i) { const int kk = 2 * i + (lane >> 5); scr[kk * 33 + (lane & 31)] = W[(size_t)(k0 + kk) * N + n0 + (lane & 31)]; }
    LDS_WAIT(); asm volatile("" ::: "memory");
    const int c = lane & 7;
#pragma unroll
    for (int j = 0; j < 4; ++j) { const int n = (lane >> 3) + 8 * j; const LAS float* s = scr + (8 * c) * 33 + n;
        v4u o; o.x = pk2(s[0 * 33], s[1 * 33]); o.y = pk2(s[2 * 33], s[3 * 33]); o.z = pk2(s[4 * 33], s[5 * 33]); o.w = pk2(s[6 * 33], s[7 * 33]);
        *(v4u*)(WT + (size_t)(r0 + n) * K + k0 + 8 * c) = o; }
    LDS_WAIT(); asm volatile("" ::: "memory");
}

template <bool HAS_Y>
__device__ __forceinline__ void row_phase(const float* res_p, const float* res_s  , const float* Y, const float* post_g, float coef,
                                          float* hout, const float* pre_g, bf16* xn, int gw, int NGW, int lane) {
    for (int row = gw; row < M; row += NGW) {
        const float* rp = (res_s && row >= MP) ? res_s + (size_t)(row - MP) * D : res_p + (size_t)row * D;
        f32x4 v[4];
#pragma unroll
        for (int j = 0; j < 4; ++j) v[j] = *((const f32x4*)rp + lane + 64 * j);
        if (HAS_Y) {
            f32x4 y[4]; float s = 0.f;
#pragma unroll
            for (int j = 0; j < 4; ++j) { y[j] = *((const f32x4*)(Y + (size_t)row * D) + lane + 64 * j); s += (y[j][0] * y[j][0] + y[j][1] * y[j][1]) + (y[j][2] * y[j][2] + y[j][3] * y[j][3]); }
            const float rstd = coef * rsqrtf(wave_sum(s) * (1.f / D) + EPS);
#pragma unroll
            for (int j = 0; j < 4; ++j) { const f32x4 g = *((const f32x4*)post_g + lane + 64 * j); v[j] = v[j] + y[j] * g * rstd; }
        }
        if (hout) {
#pragma unroll
            for (int j = 0; j < 4; ++j) *((f32x4*)(hout + (size_t)row * D) + lane + 64 * j) = v[j];
        }
        if (pre_g) {
            float s = 0.f;
#pragma unroll
            for (int j = 0; j < 4; ++j) s += (v[j][0] * v[j][0] + v[j][1] * v[j][1]) + (v[j][2] * v[j][2] + v[j][3] * v[j][3]);
            const float rstd = rsqrtf(wave_sum(s) * (1.f / D) + EPS);
            unsigned long long* o8 = (unsigned long long*)(xn + (size_t)row * D) + lane;
#pragma unroll
            for (int j = 0; j < 4; ++j) { const f32x4 g = *((const f32x4*)pre_g + lane + 64 * j); const f32x4 w = v[j] * g * rstd;
                o8[64 * j] = (unsigned long long)pk2(w[0], w[1]) | ((unsigned long long)pk2(w[2], w[3]) << 32); }
        }
    }
}

__device__ __forceinline__ float bflo(unsigned u) { return __builtin_bit_cast(float, u << 16); }
__device__ __forceinline__ float bfhi(unsigned u) { return __builtin_bit_cast(float, u & 0xffff0000u); }
__device__ __forceinline__ void r3_phase(const bf16* OP, const float* LSE, const float* OH, const float* Z, const float* attn_g, const float* hgrn_g, bf16* O, int gw, int NGW, int lane) {
    for (int row = gw; row < M; row += NGW) {
        f32x4 a0, a1;
        {
            const int hd = lane >> 3;
            const float l0 = LSE[((size_t)0 * M + row) * 8 + hd], l1 = LSE[((size_t)1 * M + row) * 8 + hd], l2 = LSE[((size_t)2 * M + row) * 8 + hd];
            const float mx = fmaxf(l0, fmaxf(l1, l2));
            float w0 = __expf(l0 - mx), w1 = __expf(l1 - mx), w2 = __expf(l2 - mx);
            const float iw = 1.f / (w0 + w1 + w2); w0 *= iw; w1 *= iw; w2 *= iw;
            const v4u p0 = *((const v4u*)(OP + ((size_t)0 * M + row) * 512) + lane), p1 = *((const v4u*)(OP + ((size_t)1 * M + row) * 512) + lane), p2 = *((const v4u*)(OP + ((size_t)2 * M + row) * 512) + lane);
            a0[0] = w0 * bflo(p0.x) + w1 * bflo(p1.x) + w2 * bflo(p2.x); a0[1] = w0 * bfhi(p0.x) + w1 * bfhi(p1.x) + w2 * bfhi(p2.x);
            a0[2] = w0 * bflo(p0.y) + w1 * bflo(p1.y) + w2 * bflo(p2.y); a0[3] = w0 * bfhi(p0.y) + w1 * bfhi(p1.y) + w2 * bfhi(p2.y);
            a1[0] = w0 * bflo(p0.z) + w1 * bflo(p1.z) + w2 * bflo(p2.z); a1[1] = w0 * bfhi(p0.z) + w1 * bfhi(p1.z) + w2 * bfhi(p2.z);
            a1[2] = w0 * bflo(p0.w) + w1 * bflo(p1.w) + w2 * bflo(p2.w); a1[3] = w0 * bfhi(p0.w) + w1 * bfhi(p1.w) + w2 * bfhi(p2.w);
        }
        float sa = (a0[0] * a0[0] + a0[1] * a0[1]) + (a0[2] * a0[2] + a0[3] * a0[3]) + (a1[0] * a1[0] + a1[1] * a1[1]) + (a1[2] * a1[2] + a1[3] * a1[3]);
        sa = wave_sum(sa);
        const float ra = rsqrtf(sa * (1.f / 512.f) + EPS);
        const f32x4 ag0 = *((const f32x4*)attn_g + 2 * lane), ag1 = *((const f32x4*)attn_g + 2 * lane + 1);
        const f32x4 oa0 = a0 * ag0 * ra, oa1 = a1 * ag1 * ra;
        v4u wa;
        wa.x = pk2(oa0[0], oa0[1]); wa.y = pk2(oa0[2], oa0[3]); wa.z = pk2(oa1[0], oa1[1]); wa.w = pk2(oa1[2], oa1[3]);
        *((v4u*)(O + (size_t)row * D) + lane) = wa;
        if (row >= MP) {
            const f32x4 h0 = *((const f32x4*)(OH + (size_t)row * 512) + 2 * lane), h1 = *((const f32x4*)(OH + (size_t)row * 512) + 2 * lane + 1);
            const f32x4 g0 = *((const f32x4*)(Z + (size_t)row * NIN + SEG_BG) + 2 * lane), g1 = *((const f32x4*)(Z + (size_t)row * NIN + SEG_BG) + 2 * lane + 1);
            float sh = (h0[0] * h0[0] + h0[1] * h0[1]) + (h0[2] * h0[2] + h0[3] * h0[3]) + (h1[0] * h1[0] + h1[1] * h1[1]) + (h1[2] * h1[2] + h1[3] * h1[3]);
#pragma unroll
            for (int o = 1; o < 16; o <<= 1) sh += __shfl_xor(sh, o);
            const float rh = rsqrtf(sh * (1.f / 128.f) + EPS);
            const f32x4 hg0 = *((const f32x4*)hgrn_g + 2 * (lane & 15)), hg1 = *((const f32x4*)hgrn_g + 2 * (lane & 15) + 1);
            const f32x4 ob0 = h0 * hg0 * rh * g0, ob1 = h1 * hg1 * rh * g1;
            v4u wb;
            wb.x = pk2(ob0[0], ob0[1]); wb.y = pk2(ob0[2], ob0[3]); wb.z = pk2(ob1[0], ob1[1]); wb.w = pk2(ob1[2], ob1[3]);
            *((v4u*)(O + (size_t)row * D + 512) + lane) = wb;
        }
    }
}

typedef float f32x2 __attribute__((ext_vector_type(2)));
struct HgIn { f32x4 f, q; float v; };
__device__ __forceinline__ void hg_load(HgIn (&d)[4], const float* Z, int rowbase, int t0, int T, int h, int kq, int vcol) {
#pragma unroll
    for (int i = 0; i < 4; ++i) {
        int t = t0 + i; t = t < T ? t : T - 1;
        const float* zr = Z + (size_t)(rowbase + t) * NIN + h * 128;
        d[i].f = *(const f32x4*)(zr + SEG_BF + kq * 4); d[i].q = *(const f32x4*)(zr + SEG_BQ + kq * 4);
        d[i].v = zr[SEG_BI + vcol];
    }
}
__device__ __forceinline__ void hg_step4(const HgIn (&d)[4], f32x2& Sa, f32x2& Sb, LAS float* scr, int slot0, int lane) {
#pragma unroll
    for (int i = 0; i < 4; ++i) {
        const f32x2 vv = {d[i].v, d[i].v};
        const f32x2 fa = {d[i].f[0], d[i].f[1]}, fb = {d[i].f[2], d[i].f[3]}, qa = {d[i].q[0], d[i].q[1]}, qb = {d[i].q[2], d[i].q[3]};
        Sa = fa * (Sa - vv) + vv; Sb = fb * (Sb - vv) + vv;
        const f32x2 pr = qa * Sa + qb * Sb;
        scr[(slot0 + i) * 64 + lane] = pr[0] + pr[1];
    }
}
template <int BS>
__device__ __forceinline__ void hgrn_task(const float* Z, float* OH, const float* s0, float* sout, int rowbase, int T, int h, int vg, LAS float* scr, int lane) {
    const int kq = lane & 31, g = lane >> 5, vcol = vg * 2 + g;
    f32x2 Sa, Sb;
    Sa[0] = s0 ? s0[(size_t)(kq * 4 + 0) * 128 + vcol] : 0.f; Sa[1] = s0 ? s0[(size_t)(kq * 4 + 1) * 128 + vcol] : 0.f;
    Sb[0] = s0 ? s0[(size_t)(kq * 4 + 2) * 128 + vcol] : 0.f; Sb[1] = s0 ? s0[(size_t)(kq * 4 + 3) * 128 + vcol] : 0.f;
    HgIn A[4], B[4];
    hg_load(A, Z, rowbase, 0, T, h, kq, vcol);
    for (int t0 = 0; t0 < T; t0 += BS) {
#pragma unroll 1
        for (int u = 0; u < BS; u += 8) {
            hg_load(B, Z, rowbase, t0 + u + 4, T, h, kq, vcol);
            hg_step4(A, Sa, Sb, scr, u, lane);
            hg_load(A, Z, rowbase, t0 + u + 8, T, h, kq, vcol);
            hg_step4(B, Sa, Sb, scr, u + 4, lane);
        }
        __builtin_amdgcn_wave_barrier(); LDS_WAIT();
        if (kq < BS) {
            float sum = 0.f;
#pragma unroll 8
            for (int i = 0; i < 32; ++i) sum += scr[kq * 64 + g * 32 + ((i + kq) & 31)];
            OH[(size_t)(rowbase + t0 + kq) * 512 + h * 128 + vcol] = sum;
        }
        __builtin_amdgcn_wave_barrier(); LDS_WAIT();
    }
    sout[(size_t)(kq * 4 + 0) * 128 + vcol] = Sa[0]; sout[(size_t)(kq * 4 + 1) * 128 + vcol] = Sa[1];
    sout[(size_t)(kq * 4 + 2) * 128 + vcol] = Sb[0]; sout[(size_t)(kq * 4 + 3) * 128 + vcol] = Sb[1];
}

typedef short bf16x8 __attribute__((ext_vector_type(8)));
typedef float f32x16 __attribute__((ext_vector_type(16)));
typedef float f32x2_t __attribute__((ext_vector_type(2))); typedef __bf16 bf16x2_t __attribute__((ext_vector_type(2)));
__device__ __forceinline__ unsigned cvtpk(float lo, float hi) { f32x2_t v = {lo, hi}; bf16x2_t b = __builtin_convertvector(v, bf16x2_t); return __builtin_bit_cast(unsigned, b); }
#define MFMA32(a, b, c) __builtin_amdgcn_mfma_f32_32x32x16_bf16((a), (b), (c), 0, 0, 0)
__device__ __forceinline__ void attn_unit(int u, const bf16* QB, const bf16* KB, const bf16* VB, bf16* OP, float* LSE, LAS unsigned char* vimg, int lane) {
    const int h = u & 7; int t = u >> 3; const int tile = t & 127; t >>= 7; const int p = t % 3, b = t / 3;
    const int sh = 2 * p, r = tile >> (7 - sh), qt = tile & ((128 >> sh) - 1);
    const int c = lane & 31, hi = lane >> 5;
    const int qrow = b * SEQ + ((32 * qt + c) << sh) + r;
    bf16x8 qf[4];
#pragma unroll
    for (int ks = 0; ks < 4; ++ks) qf[ks] = *(const bf16x8*)(QB + (size_t)qrow * 512 + h * 64 + ks * 16 + hi * 8);
    f32x16 o0, o1;
#pragma unroll
    for (int i = 0; i < 16; ++i) { o0[i] = 0.f; o1[i] = 0.f; }
    float m = -INFINITY, l = 0.f;
    const int pr = (c & 0x13) | ((c & 8) >> 1) | ((c & 4) << 1);
    const int kt0 = (qt >= 4) ? 0 : 4 - qt;
    const int kb0 = 32 * qt - 128;
    const bf16* kbase = KB + h * 64 + hi * 8; const bf16* vbase = VB + h * 64 + hi * 8;
    bf16x8 kf[2][4], vf[2][4];
#define ATT_LOAD(KT, BUF) do { const int kb_ = kb0 + 32 * (KT); const size_t kr_ = (size_t)(b * SEQ + ((kb_ + pr) << sh) + r) * 512, vr_ = (size_t)(b * SEQ + ((kb_ + c) << sh) + r) * 512; \
        _Pragma("unroll") for (int ks = 0; ks < 4; ++ks) kf[BUF][ks] = *(const bf16x8*)(kbase + kr_ + ks * 16); \
        _Pragma("unroll") for (int ks = 0; ks < 4; ++ks) vf[BUF][ks] = *(const bf16x8*)(vbase + vr_ + ks * 16); } while (0)
#pragma unroll
    for (int kt = 0; kt < 5; ++kt) {
        if (kt == kt0) ATT_LOAD(kt, kt & 1);
        if (kt >= kt0) {
            if (kt < 4) ATT_LOAD(kt + 1, (kt + 1) & 1);
            f32x16 s;
#pragma unroll
            for (int i = 0; i < 16; ++i) s[i] = 0.f;
#pragma unroll
            for (int ks = 0; ks < 4; ++ks) s = MFMA32(kf[kt & 1][ks], qf[ks], s);
#pragma unroll
            for (int ks = 0; ks < 4; ++ks)
#pragma unroll
                for (int e = 0; e < 8; ++e) *(LAS short*)(vimg + (ks * 16 + hi * 8 + e) * 80 + c * 2) = vf[kt & 1][ks][e];
            if (kt == 0) {
#pragma unroll
                for (int i = 0; i < 16; ++i) { const int ko = 16 * (i >> 3) + 8 * hi + (i & 7); s[i] = (ko >= c) ? s[i] : -INFINITY; }
            } else if (kt == 4) {
#pragma unroll
                for (int i = 0; i < 16; ++i) { const int ko = 16 * (i >> 3) + 8 * hi + (i & 7); s[i] = (ko <= c) ? s[i] : -INFINITY; }
            }
            float tmax = s[0];
#pragma unroll
            for (int i = 1; i < 16; ++i) tmax = fmaxf(tmax, s[i]);
            tmax = fmaxf(tmax, __shfl_xor(tmax, 32));
            const float mn = fmaxf(m, tmax), alpha = __expf(m - mn);
            float ls = 0.f;
#pragma unroll
            for (int i = 0; i < 16; ++i) { s[i] = __expf(s[i] - mn); ls += s[i]; }
            ls += __shfl_xor(ls, 32);
            l = l * alpha + ls; m = mn;
#pragma unroll
            for (int i = 0; i < 16; ++i) { o0[i] *= alpha; o1[i] *= alpha; }
            bf16x8 pf[2];
#pragma unroll
            for (int s2 = 0; s2 < 2; ++s2) { v4u w; w.x = cvtpk(s[8 * s2 + 0], s[8 * s2 + 1]); w.y = cvtpk(s[8 * s2 + 2], s[8 * s2 + 3]); w.z = cvtpk(s[8 * s2 + 4], s[8 * s2 + 5]); w.w = cvtpk(s[8 * s2 + 6], s[8 * s2 + 7]);
                pf[s2] = __builtin_bit_cast(bf16x8, w); }
            __builtin_amdgcn_wave_barrier(); LDS_WAIT();
#pragma unroll
            for (int s2 = 0; s2 < 2; ++s2) {
                const bf16x8 a0 = *(const LAS bf16x8*)(vimg + c * 80 + (16 * s2 + 8 * hi) * 2);
                const bf16x8 a1 = *(const LAS bf16x8*)(vimg + (32 + c) * 80 + (16 * s2 + 8 * hi) * 2);
                o0 = MFMA32(a0, pf[s2], o0); o1 = MFMA32(a1, pf[s2], o1);
            }
            __builtin_amdgcn_wave_barrier(); LDS_WAIT();
        }
    }
#undef ATT_LOAD
    const float inv = 1.f / l;
    bf16* orow = OP + ((size_t)p * M + qrow) * 512 + h * 64;
#pragma unroll
    for (int gq = 0; gq < 4; ++gq) {
        unsigned long long w0 = (unsigned long long)cvtpk(o0[4 * gq] * inv, o0[4 * gq + 1] * inv) | ((unsigned long long)cvtpk(o0[4 * gq + 2] * inv, o0[4 * gq + 3] * inv) << 32);
        unsigned long long w1 = (unsigned long long)cvtpk(o1[4 * gq] * inv, o1[4 * gq + 1] * inv) | ((unsigned long long)cvtpk(o1[4 * gq + 2] * inv, o1[4 * gq + 3] * inv) << 32);
        *(unsigned long long*)(orow + 8 * gq + 4 * hi) = w0;
        *(unsigned long long*)(orow + 32 + 8 * gq + 4 * hi) = w1;
    }
    if (hi == 0) LSE[((size_t)p * M + qrow) * 8 + h] = m + __logf(l);
}

__device__ __forceinline__ const float* skv_ptr(int b, int idx, int h, int seg, const float* Z, const float* cache, int l) {
    if (idx >= 2048) return Z + (size_t)(MP + b * 8 + (idx - 2048)) * NIN + seg + h * 64;
    return cache + ((((size_t)l * 32 + b) * 2048 + idx) * 8 + h) * 64;
}
__device__ __forceinline__ v4u aent(float c, const float* p) { v4u e; e.x = __builtin_bit_cast(unsigned, c); e.y = 0u; const unsigned long long a = (unsigned long long)p; e.z = (unsigned)a; e.w = (unsigned)(a >> 32); return e; }
__device__ __forceinline__ float dot64(const f32x4 (&q)[16], const float* kp) {
    float a0 = 0.f, a1 = 0.f, a2 = 0.f, a3 = 0.f;
#pragma unroll
    for (int i = 0; i < 16; ++i) { const f32x4 k = *((const f32x4*)kp + i); a0 = fmaf(q[i][0], k[0], a0); a1 = fmaf(q[i][1], k[1], a1); a2 = fmaf(q[i][2], k[2], a2); a3 = fmaf(q[i][3], k[3], a3); }
    return (a0 + a1) + (a2 + a3);
}
__device__ __forceinline__ void attn_sample_item(int it, int l, const float* Z, const float* ck, const float* cv, bf16* OP, float* LSE, LAS v4u* scr, int lane) {
    const int p = it % 3, h = (it / 3) & 7, rs = it / 24, b = rs >> 3, pos = 2048 + (rs & 7), row = MP + rs, d = 1 << (2 * p);
    float s0, sa, sb;
    const int ia = pos - d * (1 + lane), ib = pos - d * (65 + lane);
    {
        const float* qp = Z + (size_t)row * NIN + SEG_Q + h * 64;
        f32x4 q[16];
#pragma unroll
        for (int i = 0; i < 16; ++i) q[i] = *((const f32x4*)qp + i);
        s0 = dot64(q, skv_ptr(b, pos, h, SEG_K, Z, ck, l));
        sa = dot64(q, skv_ptr(b, ia, h, SEG_K, Z, ck, l));
        sb = dot64(q, skv_ptr(b, ib, h, SEG_K, Z, ck, l));
    }
    const float m = fmaxf(s0, wave_max(fmaxf(sa, sb)));
    const float e0 = __expf(s0 - m), ea = __expf(sa - m), eb = __expf(sb - m);
    const float lsum = e0 + wave_sum(ea + eb), inv = 1.f / lsum;
    const float* vself = skv_ptr(b, pos, h, SEG_V, Z, cv, l);
    scr[1 + lane] = aent(ea * inv, skv_ptr(b, ia, h, SEG_V, Z, cv, l));
    scr[65 + lane] = aent(eb * inv, skv_ptr(b, ib, h, SEG_V, Z, cv, l));
    if (lane < 4) scr[lane == 0 ? 0 : 128 + lane] = aent(lane == 0 ? e0 * inv : 0.f, vself);
    __builtin_amdgcn_wave_barrier(); LDS_WAIT();
    const int ks = lane >> 4, c4 = (lane & 15) * 4;
    f32x4 acc = {0.f, 0.f, 0.f, 0.f};
#pragma unroll 11
    for (int i = 0; i < 33; ++i) { const v4u e = scr[4 * i + ks]; const float* vp = (const float*)(((unsigned long long)e.w << 32) | e.z);
        const f32x4 v = *(const f32x4*)(vp + c4); acc = acc + v * __builtin_bit_cast(float, e.x); }
#pragma unroll
    for (int i = 0; i < 4; ++i) { acc[i] += __shfl_xor(acc[i], 16); acc[i] += __shfl_xor(acc[i], 32); }
    if (lane < 16) *(unsigned long long*)(OP + ((size_t)p * M + row) * 512 + h * 64 + c4) = (unsigned long long)cvtpk(acc[0], acc[1]) | ((unsigned long long)cvtpk(acc[2], acc[3]) << 32);
    if (lane == 0) LSE[((size_t)p * M + row) * 8 + h] = m + __logf(lsum);
    __builtin_amdgcn_wave_barrier(); LDS_WAIT();
}

__device__ __forceinline__ void hg_pass_a(int unit, const float* Z, float* U, float* DEC, LAS unsigned char* img, int lane) {
    const int kh = unit & 1, vh = (unit >> 1) & 1, cg = unit >> 2, c = cg & 63, seq = cg >> 6, h = seq & 3, b = seq >> 2;
    const size_t rowbase = (size_t)b * SEQ + c * 64;
    const float* zf = Z + rowbase * NIN + SEG_BF + h * 128 + kh * 64 + lane;
    const float* zv = Z + rowbase * NIN + SEG_BI + h * 128 + vh * 64 + lane;
    LAS unsigned char* imk = img; LAS unsigned char* imv = img + 9216;
    {
        float fv[64]; float tot = 0.f;
#pragma unroll
        for (int t = 0; t < 64; ++t) { fv[t] = zf[(size_t)t * NIN]; }
#pragma unroll
        for (int t = 0; t < 64; ++t) tot += __logf(fv[t]);
        float g = 0.f;
#pragma unroll
        for (int t8 = 0; t8 < 8; ++t8) {
            float kk[8];
#pragma unroll
            for (int j = 0; j < 8; ++j) { const float f = fv[t8 * 8 + j]; g += __logf(f); kk[j] = (1.f - f) * __expf(tot - g); }
            v4u w; w.x = cvtpk(kk[0], kk[1]); w.y = cvtpk(kk[2], kk[3]); w.z = cvtpk(kk[4], kk[5]); w.w = cvtpk(kk[6], kk[7]);
            *(LAS v4u*)(imk + lane * 144 + t8 * 16) = w;
        }
        if (vh == 0) DEC[(size_t)cg * 128 + kh * 64 + lane] = __expf(tot);
    }
    {
#pragma unroll
        for (int t8 = 0; t8 < 8; ++t8) {
            float vv[8];
#pragma unroll
            for (int j = 0; j < 8; ++j) vv[j] = zv[(size_t)(t8 * 8 + j) * NIN];
            v4u w; w.x = cvtpk(vv[0], vv[1]); w.y = cvtpk(vv[2], vv[3]); w.z = cvtpk(vv[4], vv[5]); w.w = cvtpk(vv[6], vv[7]);
            *(LAS v4u*)(imv + lane * 144 + t8 * 16) = w;
        }
    }
    __builtin_amdgcn_wave_barrier(); LDS_WAIT();
    const int cc = lane & 31, hi = lane >> 5;
#pragma unroll
    for (int vt = 0; vt < 2; ++vt)
#pragma unroll
        for (int kt = 0; kt < 2; ++kt) {
            f32x16 acc;
#pragma unroll
            for (int i = 0; i < 16; ++i) acc[i] = 0.f;
#pragma unroll
            for (int ts = 0; ts < 4; ++ts) {
                const bf16x8 a = *(const LAS bf16x8*)(imv + (vt * 32 + cc) * 144 + (16 * ts + 8 * hi) * 2);
                const bf16x8 bb = *(const LAS bf16x8*)(imk + (kt * 32 + cc) * 144 + (16 * ts + 8 * hi) * 2);
                acc = MFMA32(a, bb, acc);
            }
            float* up = U + ((size_t)cg * 128 + vh * 64 + vt * 32) * 128 + kh * 64 + kt * 32 + cc;
#pragma unroll
            for (int i = 0; i < 16; ++i) up[(size_t)((i & 3) + 8 * (i >> 2) + 4 * hi) * 128] = acc[i];
        }
    __builtin_amdgcn_wave_barrier(); LDS_WAIT();
}
__device__ __forceinline__ void hg_pass_b(const float* __restrict__ U, const float* __restrict__ DEC, bf16* __restrict__ SPREV, float* __restrict__ sfin, int gtid, int nthr) {
    for (int e = gtid * 2; e < 16 * 16384; e += nthr * 2) {
        const int seq = e >> 14, v = (e >> 7) & 127, k = e & 127;
        f32x2 S = {0.f, 0.f};
        const size_t eo = (size_t)v * 128 + k;
#pragma unroll 8
        for (int c = 0; c < 64; ++c) {
            const size_t cg = (size_t)seq * 64 + c;
            const f32x2 u = *(const f32x2*)(U + cg * 16384 + eo), dd = *(const f32x2*)(DEC + cg * 128 + k);
            *(unsigned*)(SPREV + cg * 16384 + eo) = cvtpk(S[0], S[1]);
            S = dd * S + u;
        }
        sfin[(size_t)seq * 16384 + (size_t)k * 128 + v] = S[0];
        sfin[(size_t)seq * 16384 + (size_t)(k + 1) * 128 + v] = S[1];
    }
}
constexpr int PC_QT = 0, PC_Q1 = 17408, PC_K0 = 26112, PC_K1 = 34816, PC_VT = 52224, PC_AM = 70656, PC_PRE = 79872, PC_RED = 81920;
__device__ __forceinline__ float exp_c(float x) { return __expf(fminf(x, 80.f)); }
__device__ __forceinline__ void hg_pass_c(int cg, const float* Z, const bf16* SPREV, const float* hgrn_g, bf16* O, LAS unsigned char* lds, int tid) {
    const int c = cg & 63, seq = cg >> 6, h = seq & 3, b = seq >> 2;
    const size_t rowbase = (size_t)b * SEQ + c * 64;
    const int kd = tid & 127, tq = tid >> 7, lane = tid & 63, wave = tid >> 6, cc = lane & 31, hi = lane >> 5;
    LAS float* PRE = (LAS float*)(lds + PC_PRE); LAS float* RED = (LAS float*)(lds + PC_RED);
    {
        const float* zr = Z + (rowbase + tq * 16) * NIN + h * 128 + kd;
        float fv[16], cs[16]; float run = 0.f;
#pragma unroll
        for (int j = 0; j < 16; ++j) fv[j] = zr[(size_t)j * NIN + SEG_BF];
#pragma unroll
        for (int j = 0; j < 16; ++j) { run += __logf(fv[j]); cs[j] = run; }
        PRE[tq * 128 + kd] = run;
        {
            float vv[16];
#pragma unroll
            for (int j = 0; j < 16; ++j) vv[j] = zr[(size_t)j * NIN + SEG_BI];
            v4u w0, w1; w0.x = cvtpk(vv[0], vv[1]); w0.y = cvtpk(vv[2], vv[3]); w0.z = cvtpk(vv[4], vv[5]); w0.w = cvtpk(vv[6], vv[7]);
            w1.x = cvtpk(vv[8], vv[9]); w1.y = cvtpk(vv[10], vv[11]); w1.z = cvtpk(vv[12], vv[13]); w1.w = cvtpk(vv[14], vv[15]);
            *(LAS v4u*)(lds + PC_VT + kd * 144 + tq * 32) = w0; *(LAS v4u*)(lds + PC_VT + kd * 144 + tq * 32 + 16) = w1;
        }
        __syncthreads();
        const float p0 = PRE[kd], p1 = PRE[128 + kd], p2 = PRE[256 + kd];
        const float pre = (tq > 0 ? p0 : 0.f) + (tq > 1 ? p1 : 0.f) + (tq > 2 ? p2 : 0.f);
        const float g31 = p0 + p1;
#pragma unroll
        for (int j = 0; j < 16; ++j) {
            const int t = tq * 16 + j;
            const float g = pre + cs[j], q = zr[(size_t)j * NIN + SEG_BQ], kk = 1.f - fv[j];
            *(LAS unsigned short*)(lds + PC_QT + t * 272 + kd * 2) = (unsigned short)cvtpk(q * __expf(g), 0.f);
            *(LAS unsigned short*)(lds + PC_K1 + t * 272 + kd * 2) = (unsigned short)cvtpk(kk * exp_c(g31 - g), 0.f);
            if (tq >= 2) *(LAS unsigned short*)(lds + PC_Q1 + (t - 32) * 272 + kd * 2) = (unsigned short)cvtpk(q * __expf(g - g31), 0.f);
            else         *(LAS unsigned short*)(lds + PC_K0 + t * 272 + kd * 2) = (unsigned short)cvtpk(kk * exp_c(-g), 0.f);
        }
    }
    __syncthreads();
    if (wave < 3) {
        const int st = (wave == 2) ? 1 : 0, tt = (wave == 0) ? 0 : 1;
        LAS unsigned char* kim = lds + (wave == 0 ? PC_K0 : PC_K1) + (wave == 2 ? 32 * 272 : 0);
        LAS unsigned char* qim = lds + (wave == 0 ? PC_QT : PC_Q1);
        f32x16 acc;
#pragma unroll
        for (int i = 0; i < 16; ++i) acc[i] = 0.f;
#pragma unroll
        for (int ks = 0; ks < 8; ++ks) {
            const bf16x8 a = *(const LAS bf16x8*)(kim + cc * 272 + (16 * ks + 8 * hi) * 2);
            const bf16x8 bq = *(const LAS bf16x8*)(qim + cc * 272 + (16 * ks + 8 * hi) * 2);
            acc = MFMA32(a, bq, acc);
        }
        if (wave != 1) {
#pragma unroll
            for (int i = 0; i < 16; ++i) { const int sl = (i & 3) + 8 * (i >> 2) + 4 * hi; acc[i] = (sl <= cc) ? acc[i] : 0.f; }
        }
#pragma unroll
        for (int gq = 0; gq < 4; ++gq)
            *(LAS unsigned long long*)(lds + PC_AM + (tt * 32 + cc) * 144 + (st * 32 + 8 * gq + 4 * hi) * 2) =
                (unsigned long long)cvtpk(acc[4 * gq], acc[4 * gq + 1]) | ((unsigned long long)cvtpk(acc[4 * gq + 2], acc[4 * gq + 3]) << 32);
    }
    __syncthreads();
    {
        const int vt = wave >> 1, tt = wave & 1;
        f32x16 acc;
#pragma unroll
        for (int i = 0; i < 16; ++i) acc[i] = 0.f;
        const bf16* sp = SPREV + (size_t)cg * 16384 + (size_t)(vt * 32 + cc) * 128 + 8 * hi;
#pragma unroll
        for (int ks = 0; ks < 8; ++ks) {
            const bf16x8 a = *(const bf16x8*)(sp + 16 * ks);
            const bf16x8 bq = *(const LAS bf16x8*)(lds + PC_QT + (tt * 32 + cc) * 272 + (16 * ks + 8 * hi) * 2);
            acc = MFMA32(a, bq, acc);
        }
#pragma unroll
        for (int ss = 0; ss < 4; ++ss) {
            if (ss < 2 || tt == 1) {
                const bf16x8 a = *(const LAS bf16x8*)(lds + PC_VT + (vt * 32 + cc) * 144 + (16 * ss + 8 * hi) * 2);
                const bf16x8 ba = *(const LAS bf16x8*)(lds + PC_AM + (tt * 32 + cc) * 144 + (16 * ss + 8 * hi) * 2);
                acc = MFMA32(a, ba, acc);
            }
        }
        float ssq = 0.f;
#pragma unroll
        for (int i = 0; i < 16; ++i) ssq += acc[i] * acc[i];
        ssq += __shfl_xor(ssq, 32);
        if (hi == 0) RED[vt * 64 + tt * 32 + cc] = ssq;
        __syncthreads();
        const int t = tt * 32 + cc;
        const float rstd = rsqrtf((RED[t] + RED[64 + t] + RED[128 + t] + RED[192 + t]) * (1.f / 128.f) + EPS);
        const size_t row = rowbase + t;
#pragma unroll
        for (int gq = 0; gq < 4; ++gq) {
            const int v0 = vt * 32 + 8 * gq + 4 * hi;
            const f32x4 gate = *(const f32x4*)(Z + row * NIN + SEG_BG + h * 128 + v0), gg = *(const f32x4*)(hgrn_g + v0);
            const float x0 = acc[4 * gq] * rstd * gg[0] * gate[0], x1 = acc[4 * gq + 1] * rstd * gg[1] * gate[1], x2 = acc[4 * gq + 2] * rstd * gg[2] * gate[2], x3 = acc[4 * gq + 3] * rstd * gg[3] * gate[3];
            *(unsigned long long*)(O + row * D + 512 + h * 128 + v0) = (unsigned long long)cvtpk(x0, x1) | ((unsigned long long)cvtpk(x2, x3) << 32);
        }
    }
    __syncthreads();
}

#define XB_TMO      128
#define XB_XCNT(j)  (256  + 64 * (j))
#define XB_XSUB(j)  (1280 + 64 * (j))
#define XB_XGEN(j)  (2304 + 64 * (j))
#define XB_TOP      3328
#define XB_TOPGEN   3392
#define XCD_BAR_WORDS 3456
#define XB_SPIN_CAP (1u << 18)

__device__ __forceinline__ unsigned xb_ld(unsigned* p)              { return __hip_atomic_load(p, __ATOMIC_RELAXED, __HIP_MEMORY_SCOPE_AGENT); }
__device__ __forceinline__ unsigned xb_add(unsigned* p, unsigned v) { return __hip_atomic_fetch_add(p, v, __ATOMIC_RELAXED, __HIP_MEMORY_SCOPE_AGENT); }
__device__ __forceinline__ unsigned xb_xcc_id() { return (unsigned)__builtin_amdgcn_s_getreg((3 << 11) | 20) & 0xFu; }
#define XB_SPIN(cond, bar) do { unsigned _sp = 0; while (cond) { __builtin_amdgcn_s_sleep(1); \
    if ((++_sp & 255u) == 0u) { if (xb_ld(&(bar)[XB_TMO])) break; if (_sp > XB_SPIN_CAP) { atomicAdd(&(bar)[XB_TMO], 1u); break; } } } } while (0)

struct XcdBarrier {
    unsigned* bar; unsigned x;
    volatile LAS unsigned* st;
};

__device__ __forceinline__ XcdBarrier xcd_barrier_post(unsigned* bar, volatile LAS unsigned* st) {
    XcdBarrier b; b.bar = bar; b.x = xb_xcc_id(); b.st = st;
    if (threadIdx.x == 0) (void)xb_add(&bar[XB_XCNT(b.x)], 1u);
    return b;
}
__device__ __forceinline__ void xcd_barrier_complete(unsigned* bar, unsigned x, unsigned& nloc, unsigned& nx) {
    const unsigned G = gridDim.x * gridDim.y * gridDim.z;
    unsigned sum, cnt, mine, sp = 0u;
    for (;;) {
        sum = 0u; cnt = 0u; mine = 0u;
#pragma unroll
        for (unsigned j = 0; j < 16; ++j) { const unsigned c = xb_ld(&bar[XB_XCNT(j)]); sum += c; cnt += (c > 0u) ? 1u : 0u; mine = (j == x) ? c : mine; }
        if (sum == G) break;
        __builtin_amdgcn_s_sleep(1);
        if ((++sp & 255u) == 0u) { if (xb_ld(&bar[XB_TMO])) break; if (sp > XB_SPIN_CAP) { atomicAdd(&bar[XB_TMO], 1u); break; } }
    }
    nloc = mine > 0u ? mine : 1u; nx = cnt > 0u ? cnt : 1u;
}

__device__ __forceinline__ void xcd_barrier(const XcdBarrier& b) {
    asm volatile("s_waitcnt vmcnt(0)" ::: "memory");
    __syncthreads();
    if (threadIdx.x == 0) {
        unsigned* bar = b.bar;
        __builtin_amdgcn_s_waitcnt(0);
        unsigned nloc = b.st[0], nx = b.st[1];
        if (nloc == 0u) { xcd_barrier_complete(bar, b.x, nloc, nx); b.st[0] = nloc; b.st[1] = nx; }
        const unsigned old = xb_add(&bar[XB_XSUB(b.x)], 1u);
        const unsigned gen = old / nloc;
        if (old + 1u == (gen + 1u) * nloc) {
            __builtin_amdgcn_fence(__ATOMIC_RELEASE, "agent");
            asm volatile("s_waitcnt vmcnt(0)" ::: "memory");
            const unsigned og = xb_add(&bar[XB_TOP], 1u);
            const unsigned tg = og / nx;
            if (og + 1u == (tg + 1u) * nx) xb_add(&bar[XB_TOPGEN], 1u);
            else XB_SPIN(xb_ld(&bar[XB_TOPGEN]) == tg, bar);
            __builtin_amdgcn_fence(__ATOMIC_ACQUIRE, "agent");
            xb_add(&bar[XB_XGEN(b.x)], 1u);
            asm volatile("s_waitcnt vmcnt(0)" ::: "memory");
        } else {
            XB_SPIN(xb_ld(&bar[XB_XGEN(b.x)]) == gen, bar);
            __builtin_amdgcn_fence(__ATOMIC_ACQUIRE, "agent");
            asm volatile("s_waitcnt vmcnt(0)" ::: "memory");
        }
    }
    __syncthreads();
}

struct Args { const float* in[22]; float* out; unsigned char* ws; int ph_lo, ph_hi; };
constexpr int N_PHASES = 25;

__global__ void __launch_bounds__(NWAVES * 64, 2) mk_fwd(Args args) {
    extern __shared__ __attribute__((aligned(16))) unsigned char lds_raw[];
    LAS unsigned char* lds = (LAS unsigned char*)lds_raw;
    const int G = gridDim.x, bx = blockIdx.x, NGW = G * NWAVES;
#define FRESH() int tid_ = threadIdx.x; asm volatile("" : "+v"(tid_)); const int tid = tid_, lane = tid & 63, wave = __builtin_amdgcn_readfirstlane(tid >> 6), gw = bx * NWAVES + wave; (void)tid; (void)lane; (void)gw;
    unsigned char* ws = args.ws;
    float* LB = (float*)(ws + WS_LB);
    bf16* Wb = (bf16*)(ws + WS_W);
    bf16* XN = (bf16*)(ws + WS_XN); bf16* OB = (bf16*)(ws + WS_O); bf16* HID = (bf16*)(ws + WS_HID);
    float* Y = (float*)(ws + WS_Y); float* HR = (float*)(ws + WS_H); float* Z = (float*)(ws + WS_Z);
    float* OH = (float*)(ws + WS_OH);
    bf16* QB = (bf16*)(ws + WS_QB); bf16* OPB = (bf16*)(ws + WS_OP); float* LSE = (float*)(ws + WS_LSE);
    float* UU = (float*)(ws + WS_U); float* DEC = (float*)(ws + WS_DEC); bf16* SPREV = (bf16*)(ws + WS_SPREV);
    float* out = args.out;
    const int lo = args.ph_lo, hi = args.ph_hi;
#define IN(k) (lo <= (k) && (k) < hi)
#define SEAM(k) do { if (IN(k) && IN((k) + 1)) { if ((k) == 0) cg::this_grid().sync(); else xcd_barrier(xbar); } } while (0)
    volatile LAS unsigned* MISC = (volatile LAS unsigned*)(lds + LDS_MISC);
    if (threadIdx.x < 2) MISC[threadIdx.x] = 0u;
    __syncthreads();
    XcdBarrier xbar = xcd_barrier_post((unsigned*)(ws + WS_BAR), MISC);

    if (IN(0)) {
        FRESH();
        LAS float* scr = (LAS float*)(lds + wave * 16384);
        constexpr int I_FF = (D / 64) * (FF / 32), I_DN = (FF / 64) * (D / 32), I_IN = (D / 64) * (NIN / 32), I_OUT = (D / 64) * (D / 32);
        constexpr int I_LAYER = 4 * I_FF + 2 * I_DN + I_IN + I_OUT;
        for (int it = gw; it < 2 * I_LAYER; it += NGW) {
            const int l = it / I_LAYER; int r = it % I_LAYER;
            bf16* wl = Wb + (size_t)l * W_LAYER;
            if (r < I_FF) { p0_transpose_item(args.in[6] + (size_t)l * D * FF, D, FF, wl + W_G1, 1, scr, r, lane); continue; } r -= I_FF;
            if (r < I_FF) { p0_transpose_item(args.in[7] + (size_t)l * D * FF, D, FF, wl + W_G1, 2, scr, r, lane); continue; } r -= I_FF;
            if (r < I_DN) { p0_transpose_item(args.in[8] + (size_t)l * D * FF, FF, D, wl + W_D1, 0, scr, r, lane); continue; } r -= I_DN;
            if (r < I_IN) { p0_transpose_item(args.in[11] + (size_t)l * D * NIN, D, NIN, wl + W_IN, 0, scr, r, lane); continue; } r -= I_IN;
            if (r < I_OUT) { p0_transpose_item(args.in[15] + (size_t)l * D * D, D, D, wl + W_OUT, 0, scr, r, lane); continue; } r -= I_OUT;
            if (r < I_FF) { p0_transpose_item(args.in[18] + (size_t)l * D * FF, D, FF, wl + W_G2, 1, scr, r, lane); continue; } r -= I_FF;
            if (r < I_FF) { p0_transpose_item(args.in[19] + (size_t)l * D * FF, D, FF, wl + W_G2, 2, scr, r, lane); continue; } r -= I_FF;
            p0_transpose_item(args.in[20] + (size_t)l * D * FF, FF, D, wl + W_D2, 0, scr, r, lane);
        }
        if (bx == 0) {
            const float* lg = args.in[13];
            const float x0 = lg[tid], x1 = lg[512 + tid];
            LB[tid] = 0.f; LB[512 + tid] = 1.f / (1.f + __expf(x0 - x1));
        }
        row_phase<false>(args.in[0], args.in[1], nullptr, nullptr, 0.f, nullptr, args.in[5], XN, gw, NGW, lane);
    }
    SEAM(0);

#pragma unroll 1
    for (int l = 0; l < 2; ++l) {
        const int pb = 1 + 12 * l;
        const bf16* wl = Wb + (size_t)l * W_LAYER;
        if (IN(pb + 0)) {
            pg8::Gemm g{XN, wl + W_G1, M, 2 * FF, D}; pg8::StaticOrder S; S.init(M, 2 * FF, G, bx);
            EpiSwiglu E{HID};
            pg8::gemm_phase<EpiSwiglu, pg8::StaticOrder, true, true>(lds, g, S, E);
        }
        SEAM(pb + 0);
        if (IN(pb + 1)) {
            pg8::Gemm g{HID, wl + W_D1, M, D, FF}; pg8::StaticOrder S; S.init(M, D, G, bx);
            EpiF32 E{Y, D};
            pg8::gemm_phase<EpiF32, pg8::StaticOrder, true, true>(lds, g, S, E);
        }
        SEAM(pb + 1);
        if (IN(pb + 2)) {
            FRESH();
            if (l == 0) row_phase<true>(args.in[0], args.in[1], Y, args.in[9] + l * D, 0.5f, HR, args.in[10] + l * D, XN, gw, NGW, lane);
            else        row_phase<true>(HR, nullptr, Y, args.in[9] + l * D, 0.5f, HR, args.in[10] + l * D, XN, gw, NGW, lane);
        }
        SEAM(pb + 2);
        if (IN(pb + 3)) {
            pg8::Gemm g{XN, wl + W_IN, M, NIN, D}; pg8::StaticOrder S; S.init(M, NIN, G, bx);
            EpiMix E{Z, LB + l * 512, out, l, QB};
            pg8::gemm_phase<EpiMix, pg8::StaticOrder, true, true>(lds, g, S, E);
        }
        SEAM(pb + 3);
        if (IN(pb + 4)) {
            FRESH();
            LAS unsigned char* wl_ = lds + wave * WLDS;
            for (int u = gw; u < 4096; u += NGW) hg_pass_a(u, Z, UU, DEC, wl_, lane);
            {
                constexpr int NU = 4 * 3 * 128 * 8;
                const int per = (NU + NGW - 1) / NGW, u0 = gw * per, u1 = (u0 + per < NU) ? u0 + per : NU;
                for (int u = u0; u < u1; ++u) attn_unit(u, QB, QB + (size_t)MP * 512, QB + (size_t)2 * MP * 512, OPB, LSE, wl_, lane);
            }
            for (int it = gw; it < MS * 24; it += NGW) attn_sample_item(it, l, Z, args.in[2], args.in[3], OPB, LSE, (LAS v4u*)wl_, lane);
            for (int task = gw; task < 8192; task += NGW) {
                const int b = task >> 8, h = (task >> 6) & 3, vg = task & 63;
                const size_t so = ((size_t)(l * 32 + b) * 4 + h) * 16384;
                hgrn_task<8>(Z, OH, args.in[4] + so, out + OFF_SS + so, MP + b * 8, 8, h, vg, (LAS float*)wl_, lane);
            }
        }
        SEAM(pb + 4);
        if (IN(pb + 5)) { FRESH(); hg_pass_b(UU, DEC, SPREV, out + OFF_SP + (size_t)l * 16 * 16384, bx * (NWAVES * 64) + tid, G * NWAVES * 64); }
        SEAM(pb + 5);
        if (IN(pb + 6)) {
            FRESH();
            for (int cg = bx; cg < 1024; cg += G) hg_pass_c(cg, Z, SPREV, args.in[14] + l * 128, OB, lds, tid);
            r3_phase(OPB, LSE, OH, Z, args.in[12] + l * 512, args.in[14] + l * 128, OB, gw, NGW, lane);
        }
        SEAM(pb + 6);
        if (IN(pb + 7)) {
            pg8::Gemm g{OB, wl + W_OUT, M, D, D}; pg8::StaticOrder S; S.init(M, D, G, bx);
            EpiF32 E{Y, D};
            pg8::gemm_phase<EpiF32, pg8::StaticOrder, true, true>(lds, g, S, E);
        }
        SEAM(pb + 7);
        if (IN(pb + 8)) { FRESH(); row_phase<true>(HR, nullptr, Y, args.in[16] + l * D, 1.0f, HR, args.in[17] + l * D, XN, gw, NGW, lane); }
        SEAM(pb + 8);
        if (IN(pb + 9)) {
            pg8::Gemm g{XN, wl + W_G2, M, 2 * FF, D}; pg8::StaticOrder S; S.init(M, 2 * FF, G, bx);
            EpiSwiglu E{HID};
            pg8::gemm_phase<EpiSwiglu, pg8::StaticOrder, true, true>(lds, g, S, E);
        }
        SEAM(pb + 9);
        if (IN(pb + 10)) {
            pg8::Gemm g{HID, wl + W_D2, M, D, FF}; pg8::StaticOrder S; S.init(M, D, G, bx);
            EpiF32 E{Y, D};
            pg8::gemm_phase<EpiF32, pg8::StaticOrder, true, true>(lds, g, S, E);
        }
        SEAM(pb + 10);
        if (IN(pb + 11)) {
            FRESH();
            if (l == 0) row_phase<true>(HR, nullptr, Y, args.in[21] + l * D, 0.5f, HR, args.in[5] + D, XN, gw, NGW, lane);
            else        row_phase<true>(HR, nullptr, Y, args.in[21] + l * D, 0.5f, out + OFF_Y, nullptr, nullptr, gw, NGW, lane);
        }
        SEAM(pb + 11);
    }
#undef IN
#undef SEAM
}

extern "C" void kernel_launch(void* const* d_in, const int* in_sizes, int n_in, void* d_out, int out_size, void* d_ws, size_t ws_size, hipStream_t stream) {
    static int grid = 0;
    if (grid == 0) {
        if (n_in != 22 || ws_size < WS_END) { fprintf(stderr, "kernel_launch: n_in %d ws %zu (need %zu)\n", n_in, ws_size, (size_t)WS_END); grid = -1; return; }
        int dev = 0, cus = 0, per_cu = 0;
        (void)hipGetDevice(&dev);
        (void)hipDeviceGetAttribute(&cus, hipDeviceAttributeMultiprocessorCount, dev);
        if (hipFuncSetAttribute((const void*)mk_fwd, hipFuncAttributeMaxDynamicSharedMemorySize, LDS_BYTES) != hipSuccess) { fprintf(stderr, "kernel_launch: hipFuncSetAttribute failed\n"); grid = -1; return; }
        if (hipOccupancyMaxActiveBlocksPerMultiprocessor(&per_cu, (const void*)mk_fwd, NWAVES * 64, LDS_BYTES) != hipSuccess || per_cu < 1) { fprintf(stderr, "kernel_launch: occupancy query says %d\n", per_cu); per_cu = 1; }
        (void)hipGetLastError();
        grid = cus * (per_cu > 1 ? 1 : per_cu);
        fprintf(stderr, "kernel_launch: grid %d (cus %d per_cu %d)\n", grid, cus, per_cu);
    }
    if (grid < 0) return;
    if (hipMemsetAsync((char*)d_ws + WS_BAR, 0, 16384, stream) != hipSuccess) { fprintf(stderr, "kernel_launch: memset failed\n"); return; }
    Args a{};
    for (int i = 0; i < 22; ++i) a.in[i] = (const float*)d_in[i];
    a.out = (float*)d_out; a.ws = (unsigned char*)d_ws;
#if MK_MULTI
    for (int p = 0; p < N_PHASES; ++p) {
        a.ph_lo = p; a.ph_hi = p + 1;
        void* kargs[] = {&a};
        hipError_t e = hipLaunchCooperativeKernel((const void*)mk_fwd, dim3(grid), dim3(NWAVES * 64), kargs, LDS_BYTES, stream);
        if (e != hipSuccess) { fprintf(stderr, "kernel_launch: launch %d failed: %s\n", p, hipGetErrorString(e)); break; }
    }
#else
    a.ph_lo = 0; a.ph_hi = N_PHASES;
    void* kargs[] = {&a};
    hipError_t e = hipLaunchCooperativeKernel((const void*)mk_fwd, dim3(grid), dim3(NWAVES * 64), kargs, LDS_BYTES, stream);
    if (e != hipSuccess) fprintf(stderr, "kernel_launch: cooperative launch failed: %s (grid %d)\n", hipGetErrorString(e), grid);
#endif
}
```

```cpp
#include <hip/hip_runtime.h>
#include <hip/hip_cooperative_groups.h>
#include <cstdio>
#include <cstdint>
namespace cg = cooperative_groups;

#ifndef MK_MULTI
#define MK_MULTI 0
#endif

namespace pg8 {
#define PG8_LAS __attribute__((address_space(3)))
typedef unsigned short bf16_t;
typedef short bf16x8 __attribute__((ext_vector_type(8)));
typedef float f32x4 __attribute__((ext_vector_type(4)));
typedef unsigned u32x4 __attribute__((ext_vector_type(4)));
constexpr int BM = 256, BK = 64, HALF = 128, HTB = HALF * BK * 2  , STAGE_BYTES = 8 * HTB, NXCD = 8, WGM = 8;

__host__ __device__ __forceinline__ int lds_byte(int r, int c) { const int st = (r >> 4) * 2 + (c >> 5), rr = r & 15, cc = c & 31, ob = rr * 64 + cc * 2; return st * 1024 + (ob ^ (((ob >> 9) & 1) << 5)); }
__host__ __device__ __forceinline__ void stage_rc(int b, int& R, int& C) { const int st = b / 1024, sb = b % 1024, swz = sb ^ (((sb >> 9) & 1) << 5); R = (st >> 1) * 16 + swz / 64; C = (st & 1) * 32 + (swz % 64) / 2; }
__host__ __device__ __forceinline__ int perm32(int rho) { const int n = rho >> 4, i = rho & 15; return 8 * (i >> 2) + 4 * n + (i & 3); }

struct Unit { int pm, pn; };
struct Gemm { const bf16_t* A; const bf16_t* Bt; int M, N, K; };

struct StaticOrder {
    int nM, nN, nwg, G, c;
    __host__ __device__ void init(int M, int N, int G_, int c_) { nM = M / BM; nN = N / BM; nwg = nM * nN; G = G_; c = c_; }
    __host__ __device__ bool next(int i, Unit& u) const {
        const long L = (long)i * G + c; if (L >= nwg) return false;
        int wgid = (int)L; { const int q = nwg / NXCD, r = nwg % NXCD, xcd = wgid % NXCD, off = wgid / NXCD; wgid = (xcd < r ? xcd * (q + 1) : r * (q + 1) + (xcd - r) * q) + off; }
        const int nig = WGM * nN, gid = wgid / nig, fm = gid * WGM, gsz = (nM - fm) < WGM ? (nM - fm) : WGM;
        u.pm = fm + ((wgid % nig) % gsz); u.pn = (wgid % nig) / gsz; return true;
    }
    __device__ __forceinline__ void a_ready(const Unit&) const {}
    __device__ __forceinline__ void done(const Unit&) const {}
};

template <class Epi, class Sched, bool ALIGN_EPI = false, bool SP2 = false>
__device__ __forceinline__ void gemm_phase(PG8_LAS unsigned char* lds, const Gemm g, const Sched& S, const Epi& E) {
    int tid_ = threadIdx.x; asm volatile("" : "+v"(tid_));
    const int tid = tid_, wid = __builtin_amdgcn_readfirstlane(tid >> 6), lane = tid & 63, wr = wid >> 2, wc = wid & 3, fr = lane & 15, fq = lane >> 4;
    const int K = g.K, nt = K / BK;
    unsigned voffA[2], voffB[2];
#pragma unroll
    for (int i = 0; i < 2; ++i) { int R, C; stage_rc(tid * 16 + i * 8192, R, C); const int Rb = Epi::PERM ? ((R & ~31) + perm32(R & 31)) : R;
        voffA[i] = (unsigned)(R * K + C) * 2u; voffB[i] = (unsigned)(Rb * K + C) * 2u; }
    const size_t kstep = (size_t)(BK * 2);
    const size_t hstep = (size_t)HALF * K * 2;
    const size_t tstep = 2 * hstep;
    const unsigned ldsw = (unsigned)wid * 1024u;
    const int aoff = lds_byte(wr * 64 + fr, fq * 8), boff = lds_byte(wc * 32 + fr, fq * 8);
#define PG8_SA(b, h) (((b) * 2 + (h)) * HTB)
#define PG8_SB(b, h) ((4 + (b) * 2 + (h)) * HTB)
#define PG8_STAGE(bufoff, gbase, voff) do { _Pragma("unroll") for (int _i = 0; _i < 2; ++_i) \
        __builtin_amdgcn_global_load_lds((const unsigned*)((const char*)(gbase) + (voff)[_i]), (PG8_LAS unsigned*)(lds + (bufoff) + ldsw + _i * 8192), 16, 0, 0); } while (0)
#define PG8_LDA(dst, b, h) do { _Pragma("unroll") for (int m = 0; m < 4; ++m) _Pragma("unroll") for (int k = 0; k < 2; ++k) dst[m][k] = *(const PG8_LAS bf16x8*)(lds + PG8_SA(b, h) + aoff + m * 2048 + k * 1024); } while (0)
#define PG8_LDB(dst, b, h) do { _Pragma("unroll") for (int n = 0; n < 2; ++n) _Pragma("unroll") for (int k = 0; k < 2; ++k) dst[n][k] = *(const PG8_LAS bf16x8*)(lds + PG8_SB(b, h) + boff + n * 2048 + k * 1024); } while (0)
#define PG8_MMA(ai, bj, At, Bt) do { __builtin_amdgcn_s_setprio(1); _Pragma("unroll") for (int m = 0; m < 4; ++m) _Pragma("unroll") for (int n = 0; n < 2; ++n) _Pragma("unroll") for (int k = 0; k < 2; ++k) \
        acc[ai][bj][m][n] = __builtin_amdgcn_mfma_f32_16x16x32_bf16(Bt[n][k], At[m][k], acc[ai][bj][m][n], 0, 0, 0); __builtin_amdgcn_s_setprio(0); } while (0)
#define PG8_WAIT_V(n) asm volatile("s_waitcnt vmcnt(" #n ")" ::: "memory")
#define PG8_WAIT_L(n) asm volatile("s_waitcnt lgkmcnt(" #n ")" ::: "memory")
#define PG8_BAR __builtin_amdgcn_s_barrier()
#define PG8_SCHED __builtin_amdgcn_sched_barrier(0)
    Unit cur, nxt; int ui = 0;
    if (!S.next(0, cur)) return;
    f32x4 acc[2][2][4][2];
#pragma unroll
    for (int a = 0; a < 2; ++a)
#pragma unroll
        for (int b = 0; b < 2; ++b)
#pragma unroll
            for (int m = 0; m < 4; ++m)
#pragma unroll
                for (int n = 0; n < 2; ++n) acc[a][b][m][n] = (f32x4){0.f, 0.f, 0.f, 0.f};
    bf16x8 At[4][2], B0[2][2], B1[2][2];
    const char* cA = (const char*)g.A + (size_t)cur.pm * tstep; const char* cB = (const char*)g.Bt + (size_t)cur.pn * tstep;
    S.a_ready(cur);
    if constexpr (SP2) {
        PG8_STAGE(PG8_SB(0, 0), cB, voffB); PG8_STAGE(PG8_SB(0, 1), cB + hstep, voffB); PG8_STAGE(PG8_SA(0, 0), cA, voffA); PG8_STAGE(PG8_SA(0, 1), cA + hstep, voffA);
        if (wr == 1) PG8_BAR;
        PG8_WAIT_V(2); PG8_BAR;
        PG8_STAGE(PG8_SB(1, 0), cB + kstep, voffB); PG8_STAGE(PG8_SA(1, 0), cA + kstep, voffA); PG8_STAGE(PG8_SB(1, 1), cB + hstep + kstep, voffB);
        PG8_WAIT_V(6); PG8_BAR;
    } else {
        PG8_STAGE(PG8_SB(0, 0), cB, voffB); PG8_STAGE(PG8_SA(0, 0), cA, voffA); PG8_STAGE(PG8_SB(0, 1), cB + hstep, voffB); PG8_STAGE(PG8_SA(0, 1), cA + hstep, voffA);
        if (wr == 1) PG8_BAR;
        PG8_WAIT_V(4); PG8_BAR;
        PG8_STAGE(PG8_SB(1, 0), cB + kstep, voffB); PG8_STAGE(PG8_SA(1, 0), cA + kstep, voffA); PG8_STAGE(PG8_SB(1, 1), cB + hstep + kstep, voffB);
        PG8_WAIT_V(6); PG8_BAR;
    }
    for (;;) {
        const bool has_next = S.next(ui + 1, nxt);
        const char* nA = has_next ? (const char*)g.A + (size_t)nxt.pm * tstep : cA; const char* nB = has_next ? (const char*)g.Bt + (size_t)nxt.pn * tstep : cB;
        for (int t = 0; t < nt; t += 2) {
            const bool last = (t == nt - 2);
            const char* a1 = cA + (size_t)(t + 1) * kstep;
            const char* a2 = last ? nA : cA + (size_t)(t + 2) * kstep; const char* b2 = last ? nB : cB + (size_t)(t + 2) * kstep;
            const char* a3 = a2 + kstep; const char* b3 = b2 + kstep;
            if (last && has_next) S.a_ready(nxt);
            if constexpr (SP2) {
            PG8_LDB(B0, 0, 0); PG8_LDB(B1, 0, 1); PG8_SCHED; PG8_LDA(At, 0, 0); PG8_STAGE(PG8_SA(1, 1), a1 + hstep, voffA);
            PG8_WAIT_V(8); PG8_WAIT_L(0); PG8_BAR; PG8_MMA(0, 0, At, B0); PG8_MMA(0, 1, At, B1); PG8_BAR; PG8_SCHED;
            PG8_LDA(At, 0, 1); PG8_STAGE(PG8_SB(0, 0), b2, voffB); PG8_STAGE(PG8_SB(0, 1), b2 + hstep, voffB); PG8_STAGE(PG8_SA(0, 0), a2, voffA);
            PG8_WAIT_V(8); PG8_WAIT_L(0); PG8_BAR; PG8_MMA(1, 0, At, B0); PG8_MMA(1, 1, At, B1); PG8_BAR; PG8_SCHED;
            PG8_LDB(B0, 1, 0); PG8_LDB(B1, 1, 1); PG8_SCHED; PG8_LDA(At, 1, 0); PG8_STAGE(PG8_SA(0, 1), a2 + hstep, voffA);
            PG8_WAIT_V(8); PG8_WAIT_L(0); PG8_BAR; PG8_MMA(0, 0, At, B0); PG8_MMA(0, 1, At, B1); PG8_BAR; PG8_SCHED;
            PG8_LDA(At, 1, 1); PG8_STAGE(PG8_SB(1, 0), b3, voffB); PG8_STAGE(PG8_SB(1, 1), b3 + hstep, voffB); PG8_STAGE(PG8_SA(1, 0), a3, voffA);
            PG8_WAIT_V(8); PG8_WAIT_L(0); PG8_BAR; PG8_MMA(1, 0, At, B0); PG8_MMA(1, 1, At, B1); PG8_BAR; PG8_SCHED;
            } else {
            PG8_LDB(B0, 0, 0); PG8_SCHED; PG8_LDA(At, 0, 0); PG8_STAGE(PG8_SA(1, 1), a1 + hstep, voffA);
            PG8_WAIT_L(8); PG8_BAR; PG8_WAIT_L(0); PG8_MMA(0, 0, At, B0); PG8_BAR; PG8_SCHED;
            PG8_LDB(B1, 0, 1); PG8_STAGE(PG8_SB(0, 0), b2, voffB);
            PG8_BAR; PG8_WAIT_L(0); PG8_MMA(0, 1, At, B1); PG8_BAR;
            PG8_LDA(At, 0, 1); PG8_STAGE(PG8_SA(0, 0), a2, voffA);
            PG8_BAR; PG8_WAIT_L(0); PG8_MMA(1, 0, At, B0); PG8_BAR; PG8_SCHED;
            PG8_STAGE(PG8_SB(0, 1), b2 + hstep, voffB);
            PG8_WAIT_V(6); PG8_BAR; PG8_MMA(1, 1, At, B1); PG8_BAR;
            PG8_LDB(B0, 1, 0); PG8_SCHED; PG8_LDA(At, 1, 0); PG8_STAGE(PG8_SA(0, 1), a2 + hstep, voffA);
            PG8_WAIT_L(8); PG8_BAR; PG8_WAIT_L(0); PG8_MMA(0, 0, At, B0); PG8_BAR; PG8_SCHED;
            PG8_LDB(B1, 1, 1); PG8_STAGE(PG8_SB(1, 0), b3, voffB);
            PG8_BAR; PG8_WAIT_L(0); PG8_MMA(0, 1, At, B1); PG8_BAR;
            PG8_LDA(At, 1, 1); PG8_STAGE(PG8_SA(1, 0), a3, voffA);
            PG8_BAR; PG8_WAIT_L(0); PG8_MMA(1, 0, At, B0); PG8_BAR; PG8_SCHED;
            PG8_STAGE(PG8_SB(1, 1), b3 + hstep, voffB);
            PG8_WAIT_V(6); PG8_BAR; PG8_MMA(1, 1, At, B1); PG8_BAR;
            }
        }
        if constexpr (ALIGN_EPI) { if (wr == 0) PG8_BAR; }
        if constexpr (!Epi::AFTER_DRAIN) { E(acc, cur, wr, wc, fr, fq); S.done(cur); }
        if (!has_next) break;
#pragma unroll
        for (int a = 0; a < 2; ++a)
#pragma unroll
            for (int b = 0; b < 2; ++b)
#pragma unroll
                for (int m = 0; m < 4; ++m)
#pragma unroll
                    for (int n = 0; n < 2; ++n) acc[a][b][m][n] = (f32x4){0.f, 0.f, 0.f, 0.f};
        cur = nxt; cA = nA; cB = nB; ++ui;
        if constexpr (ALIGN_EPI) { if (wr == 1) PG8_BAR; }
    }
    PG8_WAIT_V(0);
    if constexpr (!ALIGN_EPI) { if (wr == 0) PG8_BAR; }
    PG8_BAR;
    if constexpr (Epi::AFTER_DRAIN) { E.fused(acc, cur, wr, wc, fr, fq, lds, wid, lane); S.done(cur); }
#undef PG8_SA
#undef PG8_SB
#undef PG8_STAGE
#undef PG8_LDA
#undef PG8_LDB
#undef PG8_MMA
#undef PG8_WAIT_V
#undef PG8_WAIT_L
#undef PG8_BAR
#undef PG8_SCHED
}
}

constexpr int NWAVES = 8;
constexpr int D = 1024, FF = 2816, NIN = 3584, MP = 16384, MS = 256, M = MP + MS, SEQ = 4096;
constexpr int SEG_Q = 0, SEG_K = 512, SEG_V = 1024, SEG_BQ = 1536, SEG_BF = 2048, SEG_BI = 2560, SEG_BG = 3072;
constexpr float EPS = 1e-6f;
constexpr size_t OFF_Y = 0, OFF_KP = 17039360, OFF_VP = 25427968, OFF_SP = 33816576, OFF_KS = 34340864, OFF_VS = 34603008, OFF_SS = 34865152;
constexpr size_t MiB = 1u << 20;
constexpr size_t WS_LB = 0;
constexpr size_t WS_BAR = 65536;
constexpr size_t WS_W = 1 * MiB;
constexpr size_t W_G1 = 0, W_D1 = W_G1 + (size_t)2 * FF * D, W_IN = W_D1 + (size_t)D * FF, W_OUT = W_IN + (size_t)NIN * D,
                 W_G2 = W_OUT + (size_t)D * D, W_D2 = W_G2 + (size_t)2 * FF * D, W_LAYER = W_D2 + (size_t)D * FF;
constexpr size_t WS_XN = WS_W + 2 * W_LAYER * 2;
constexpr size_t WS_O = WS_XN + (size_t)M * D * 2;
constexpr size_t WS_HID = WS_O + (size_t)M * D * 2;
constexpr size_t WS_Y = WS_HID + (size_t)M * FF * 2;
constexpr size_t WS_H = WS_Y + (size_t)M * D * 4;
constexpr size_t WS_Z = WS_H + (size_t)M * D * 4;
constexpr size_t WS_OA = WS_Z + (size_t)M * NIN * 4;
constexpr size_t WS_OH = WS_OA + (size_t)M * 512 * 4;
constexpr size_t WS_QB = WS_OH + (size_t)M * 512 * 4;
constexpr size_t WS_KB = WS_QB + (size_t)MP * 512 * 2;
constexpr size_t WS_VB = WS_KB + (size_t)MP * 512 * 2;
constexpr size_t WS_OP = WS_VB + (size_t)MP * 512 * 2;
constexpr size_t WS_LSE = WS_OP + (size_t)3 * M * 512 * 2;
constexpr size_t WS_U = WS_LSE + (size_t)3 * M * 8 * 4;
constexpr size_t WS_DEC = WS_U + (size_t)1024 * 16384 * 4;
constexpr size_t WS_SPREV = WS_DEC + (size_t)1024 * 128 * 4;
constexpr size_t WS_END = WS_SPREV + (size_t)1024 * 16384 * 2;
constexpr int LDS_BYTES = 147456 + 256, LDS_MISC = 147456, WLDS = 18432;

#define GAS __attribute__((address_space(1)))
#define LAS __attribute__((address_space(3)))
typedef unsigned short bf16;
typedef unsigned v4u __attribute__((ext_vector_type(4)));
typedef float f32x4 __attribute__((ext_vector_type(4)));
#define LDS_WAIT() asm volatile("s_waitcnt lgkmcnt(0)" ::: "memory")

__device__ __forceinline__ unsigned f2bf(float f) { unsigned u = __builtin_bit_cast(unsigned, f); return (u + 0x7fffu + ((u >> 16) & 1u)) >> 16; }
__device__ __forceinline__ unsigned pk2(float lo, float hi) { return f2bf(lo) | (f2bf(hi) << 16); }
__device__ __forceinline__ float silu_f(float x) { return x * __frcp_rn(1.f + __expf(-x)); }
__device__ __forceinline__ float sigmoid_f(float x) { return __frcp_rn(1.f + __expf(-x)); }
__device__ __forceinline__ float wave_sum(float v) {
#pragma unroll
    for (int o = 1; o < 64; o <<= 1) v += __shfl_xor(v, o);
    return v;
}
__device__ __forceinline__ float wave_max(float v) {
#pragma unroll
    for (int o = 1; o < 64; o <<= 1) v = fmaxf(v, __shfl_xor(v, o));
    return v;
}

struct EpiSwiglu {
    static constexpr bool PERM = true, AFTER_DRAIN = false;
    bf16* H;
    __device__ __forceinline__ void operator()(const pg8::f32x4 (&acc)[2][2][4][2], const pg8::Unit& u, int wr, int wc, int fr, int fq) const {
        const int row0 = u.pm * 256 + wr * 64 + fr, col0 = u.pn * 128 + wc * 32 + 8 * fq;
#pragma unroll
        for (int ai = 0; ai < 2; ++ai)
#pragma unroll
            for (int m = 0; m < 4; ++m) {
                bf16* rowp = H + (size_t)(row0 + ai * 128 + m * 16) * FF + col0;
                const pg8::f32x4 g0 = acc[ai][0][m][0], g1 = acc[ai][0][m][1], u0 = acc[ai][1][m][0], u1 = acc[ai][1][m][1];
                v4u w;
                w.x = pk2(silu_f(g0[0]) * u0[0], silu_f(g0[1]) * u0[1]); w.y = pk2(silu_f(g0[2]) * u0[2], silu_f(g0[3]) * u0[3]);
                w.z = pk2(silu_f(g1[0]) * u1[0], silu_f(g1[1]) * u1[1]); w.w = pk2(silu_f(g1[2]) * u1[2], silu_f(g1[3]) * u1[3]);
                *(v4u*)rowp = w;
            }
    }
};
struct EpiF32 {
    static constexpr bool PERM = true, AFTER_DRAIN = false;
    float* Y; int ldc;
    __device__ __forceinline__ void operator()(const pg8::f32x4 (&acc)[2][2][4][2], const pg8::Unit& u, int wr, int wc, int fr, int fq) const {
        const int row0 = u.pm * 256 + wr * 64 + fr, col0 = u.pn * 256 + wc * 32 + 8 * fq;
#pragma unroll
        for (int ai = 0; ai < 2; ++ai)
#pragma unroll
            for (int m = 0; m < 4; ++m) {
                float* rowp = Y + (size_t)(row0 + ai * 128 + m * 16) * ldc + col0;
#pragma unroll
                for (int bj = 0; bj < 2; ++bj)
#pragma unroll
                    for (int n = 0; n < 2; ++n) *(f32x4*)(rowp + bj * 128 + 4 * n) = acc[ai][bj][m][n];
            }
    }
};
struct EpiMix {
    static constexpr bool PERM = true, AFTER_DRAIN = false;
    float* Z; const float* lb; float* out; int l; bf16* QKV;
    __device__ __forceinline__ void operator()(const pg8::f32x4 (&acc)[2][2][4][2], const pg8::Unit& u, int wr, int wc, int fr, int fq) const {
        const int seg = u.pn >> 1;
        const int row0 = u.pm * 256 + wr * 64 + fr, cs0 = (u.pn & 1) * 256 + wc * 32 + 8 * fq;
        f32x4 lbv[2][2];
#pragma unroll
        for (int bj = 0; bj < 2; ++bj)
#pragma unroll
            for (int n = 0; n < 2; ++n) lbv[bj][n] = (seg == 4) ? *(const f32x4*)(lb + cs0 + bj * 128 + 4 * n) : (f32x4){0.f, 0.f, 0.f, 0.f};
#pragma unroll
        for (int ai = 0; ai < 2; ++ai)
#pragma unroll
            for (int m = 0; m < 4; ++m) {
                const int row = row0 + ai * 128 + m * 16;
                float* zrow = Z + (size_t)row * NIN + seg * 512 + cs0;
                float* orow = nullptr;
                f32x4 vv[2][2];
                if (seg == 1 || seg == 2) {
                    if (row < MP) { const int b = row >> 12, t = row & 4095;
                        if (t >= 2048) orow = out + (seg == 1 ? OFF_KP : OFF_VP) + ((size_t)(l * 4 + b) * 2048 + (t - 2048)) * 512 + cs0; }
                    else orow = out + (seg == 1 ? OFF_KS : OFF_VS) + ((size_t)l * 256 + (row - MP)) * 512 + cs0;
                }
#pragma unroll
                for (int bj = 0; bj < 2; ++bj)
#pragma unroll
                    for (int n = 0; n < 2; ++n) {
                        f32x4 v = acc[ai][bj][m][n];
                        if (seg == 0) v = v * 0.125f;
                        else if (seg == 3 || seg == 6) { v[0] = silu_f(v[0]); v[1] = silu_f(v[1]); v[2] = silu_f(v[2]); v[3] = silu_f(v[3]); }
                        else if (seg == 4) {
                            const f32x4 b4 = lbv[bj][n];
#pragma unroll
                            for (int i = 0; i < 4; ++i) v[i] = b4[i] + (1.f - b4[i]) * sigmoid_f(v[i]);
                        }
                        if (!(seg < 3 && row < MP)) *(f32x4*)(zrow + bj * 128 + 4 * n) = v;
                        if (orow) *(f32x4*)(orow + bj * 128 + 4 * n) = v;
                        vv[bj][n] = v;
                    }
                if (seg < 3 && row < MP) {
                    bf16* qrow = QKV + (size_t)seg * MP * 512 + (size_t)row * 512 + cs0;
#pragma unroll
                    for (int bj = 0; bj < 2; ++bj) { v4u w; w.x = pk2(vv[bj][0][0], vv[bj][0][1]); w.y = pk2(vv[bj][0][2], vv[bj][0][3]); w.z = pk2(vv[bj][1][0], vv[bj][1][1]); w.w = pk2(vv[bj][1][2], vv[bj][1][3]);
                        *(v4u*)(qrow + bj * 128) = w; }
                }
            }
    }
};

__device__ __forceinline__ void p0_transpose_item(const float* W, int K, int N, bf16* WT, int mode, LAS float* scr, int item, int lane) {
    const int nblk = N / 32, kb = item / nblk, nb = item % nblk, k0 = 64 * kb, n0 = 32 * nb;
    const int r0 = (mode == 0) ? n0 : ((n0 >> 7) * 256 + (mode - 1) * 128 + (n0 & 127));
#pragma unroll 8
    for (int i = 0; i < 32; ++i) { const int kk = 2 * i + (lane >> 5); scr[kk * 33 + (lane & 31)] = W[(size_t)(k0 + kk) * N + n0 + (lane & 31)]; }
    LDS_WAIT(); asm volatile("" ::: "memory");
    const int c = lane & 7;
#pragma unroll
    for (int j = 0; j < 4; ++j) { const int n = (lane >> 3) + 8 * j; const LAS float* s = scr + (8 * c) * 33 + n;
        v4u o; o.x = pk2(s[0 * 33], s[1 * 33]); o.y = pk2(s[2 * 33], s[3 * 33]); o.z = pk2(s[4 * 33], s[5 * 33]); o.w = pk2(s[6 * 33], s[7 * 33]);
        *(v4u*)(WT + (size_t)(r0 + n) * K + k0 + 8 * c) = o; }
    LDS_WAIT(); asm volatile("" ::: "memory");
}

template <bool HAS_Y>
__device__ __forceinline__ void row_phase(const float* res_p, const float* res_s  , const float* Y, const float* post_g, float coef,
                                          float* hout, const float* pre_g, bf16* xn, int gw, int NGW, int lane) {
    for (int row = gw; row < M; row += NGW) {
        const float* rp = (res_s && row >= MP) ? res_s + (size_t)(row - MP) * D : res_p + (size_t)row * D;
        f32x4 v[4];
#pragma unroll
        for (int j = 0; j < 4; ++j) v[j] = *((const f32x4*)rp + lane + 64 * j);
        if (HAS_Y) {
            f32x4 y[4]; float s = 0.f;
#pragma unroll
            for (int j = 0; j < 4; ++j) { y[j] = *((const f32x4*)(Y + (size_t)row * D) + lane + 64 * j); s += (y[j][0] * y[j][0] + y[j][1] * y[j][1]) + (y[j][2] * y[j][2] + y[j][3] * y[j][3]); }
            const float rstd = coef * rsqrtf(wave_sum(s) * (1.f / D) + EPS);
#pragma unroll
            for (int j = 0; j < 4; ++j) { const f32x4 g = *((const f32x4*)post_g + lane + 64 * j); v[j] = v[j] + y[j] * g * rstd; }
        }
        if (hout) {
#pragma unroll
            for (int j = 0; j < 4; ++j) *((f32x4*)(hout + (size_t)row * D) + lane + 64 * j) = v[j];
        }
        if (pre_g) {
            float s = 0.f;
#pragma unroll
            for (int j = 0; j < 4; ++j) s += (v[j][0] * v[j][0] + v[j][1] * v[j][1]) + (v[j][2] * v[j][2] + v[j][3] * v[j][3]);
            const float rstd = rsqrtf(wave_sum(s) * (1.f / D) + EPS);
            unsigned long long* o8 = (unsigned long long*)(xn + (size_t)row * D) + lane;
#pragma unroll
            for (int j = 0; j < 4; ++j) { const f32x4 g = *((const f32x4*)pre_g + lane + 64 * j); const f32x4 w = v[j] * g * rstd;
                o8[64 * j] = (unsigned long long)pk2(w[0], w[1]) | ((unsigned long long)pk2(w[2], w[3]) << 32); }
        }
    }
}

__device__ __forceinline__ float bflo(unsigned u) { return __builtin_bit_cast(float, u << 16); }
__device__ __forceinline__ float bfhi(unsigned u) { return __builtin_bit_cast(float, u & 0xffff0000u); }
__device__ __forceinline__ void r3_phase(const bf16* OP, const float* LSE, const float* OH, const float* Z, const float* attn_g, const float* hgrn_g, bf16* O, int gw, int NGW, int lane) {
    for (int row = gw; row < M; row += NGW) {
        f32x4 a0, a1;
        {
            const int hd = lane >> 3;
            const float l0 = LSE[((size_t)0 * M + row) * 8 + hd], l1 = LSE[((size_t)1 * M + row) * 8 + hd], l2 = LSE[((size_t)2 * M + row) * 8 + hd];
            const float mx = fmaxf(l0, fmaxf(l1, l2));
            float w0 = __expf(l0 - mx), w1 = __expf(l1 - mx), w2 = __expf(l2 - mx);
            const float iw = 1.f / (w0 + w1 + w2); w0 *= iw; w1 *= iw; w2 *= iw;
            const v4u p0 = *((const v4u*)(OP + ((size_t)0 * M + row) * 512) + lane), p1 = *((const v4u*)(OP + ((size_t)1 * M + row) * 512) + lane), p2 = *((const v4u*)(OP + ((size_t)2 * M + row) * 512) + lane);
            a0[0] = w0 * bflo(p0.x) + w1 * bflo(p1.x) + w2 * bflo(p2.x); a0[1] = w0 * bfhi(p0.x) + w1 * bfhi(p1.x) + w2 * bfhi(p2.x);
            a0[2] = w0 * bflo(p0.y) + w1 * bflo(p1.y) + w2 * bflo(p2.y); a0[3] = w0 * bfhi(p0.y) + w1 * bfhi(p1.y) + w2 * bfhi(p2.y);
            a1[0] = w0 * bflo(p0.z) + w1 * bflo(p1.z) + w2 * bflo(p2.z); a1[1] = w0 * bfhi(p0.z) + w1 * bfhi(p1.z) + w2 * bfhi(p2.z);
            a1[2] = w0 * bflo(p0.w) + w1 * bflo(p1.w) + w2 * bflo(p2.w); a1[3] = w0 * bfhi(p0.w) + w1 * bfhi(p1.w) + w2 * bfhi(p2.w);
        }
        float sa = (a0[0] * a0[0] + a0[1] * a0[1]) + (a0[2] * a0[2] + a0[3] * a0[3]) + (a1[0] * a1[0] + a1[1] * a1[1]) + (a1[2] * a1[2] + a1[3] * a1[3]);
        sa = wave_sum(sa);
        const float ra = rsqrtf(sa * (1.f / 512.f) + EPS);
        const f32x4 ag0 = *((const f32x4*)attn_g + 2 * lane), ag1 = *((const f32x4*)attn_g + 2 * lane + 1);
        const f32x4 oa0 = a0 * ag0 * ra, oa1 = a1 * ag1 * ra;
        v4u wa;
        wa.x = pk2(oa0[0], oa0[1]); wa.y = pk2(oa0[2], oa0[3]); wa.z = pk2(oa1[0], oa1[1]); wa.w = pk2(oa1[2], oa1[3]);
        *((v4u*)(O + (size_t)row * D) + lane) = wa;
        if (row >= MP) {
            const f32x4 h0 = *((const f32x4*)(OH + (size_t)row * 512) + 2 * lane), h1 = *((const f32x4*)(OH + (size_t)row * 512) + 2 * lane + 1);
            const f32x4 g0 = *((const f32x4*)(Z + (size_t)row * NIN + SEG_BG) + 2 * lane), g1 = *((const f32x4*)(Z + (size_t)row * NIN + SEG_BG) + 2 * lane + 1);
            float sh = (h0[0] * h0[0] + h0[1] * h0[1]) + (h0[2] * h0[2] + h0[3] * h0[3]) + (h1[0] * h1[0] + h1[1] * h1[1]) + (h1[2] * h1[2] + h1[3] * h1[3]);
#pragma unroll
            for (int o = 1; o < 16; o <<= 1) sh += __shfl_xor(sh, o);
            const float rh = rsqrtf(sh * (1.f / 128.f) + EPS);
            const f32x4 hg0 = *((const f32x4*)hgrn_g + 2 * (lane & 15)), hg1 = *((const f32x4*)hgrn_g + 2 * (lane & 15) + 1);
            const f32x4 ob0 = h0 * hg0 * rh * g0, ob1 = h1 * hg1 * rh * g1;
            v4u wb;
            wb.x = pk2(ob0[0], ob0[1]); wb.y = pk2(ob0[2], ob0[3]); wb.z = pk2(ob1[0], ob1[1]); wb.w = pk2(ob1[2], ob1[3]);
            *((v4u*)(O + (size_t)row * D + 512) + lane) = wb;
        }
    }
}

typedef float f32x2 __attribute__((ext_vector_type(2)));
struct HgIn { f32x4 f, q; float v; };
__device__ __forceinline__ void hg_load(HgIn (&d)[4], const float* Z, int rowbase, int t0, int T, int h, int kq, int vcol) {
#pragma unroll
    for (int i = 0; i < 4; ++i) {
        int t = t0 + i; t = t < T ? t : T - 1;
        const float* zr = Z + (size_t)(rowbase + t) * NIN + h * 128;
        d[i].f = *(const f32x4*)(zr + SEG_BF + kq * 4); d[i].q = *(const f32x4*)(zr + SEG_BQ + kq * 4);
        d[i].v = zr[SEG_BI + vcol];
    }
}
__device__ __forceinline__ void hg_step4(const HgIn (&d)[4], f32x2& Sa, f32x2& Sb, LAS float* scr, int slot0, int lane) {
#pragma unroll
    for (int i = 0; i < 4; ++i) {
        const f32x2 vv = {d[i].v, d[i].v};
        const f32x2 fa = {d[i].f[0], d[i].f[1]}, fb = {d[i].f[2], d[i].f[3]}, qa = {d[i].q[0], d[i].q[1]}, qb = {d[i].q[2], d[i].q[3]};
        Sa = fa * (Sa - vv) + vv; Sb = fb * (Sb - vv) + vv;
        const f32x2 pr = qa * Sa + qb * Sb;
        scr[(slot0 + i) * 64 + lane] = pr[0] + pr[1];
    }
}
template <int BS>
__device__ __forceinline__ void hgrn_task(const float* Z, float* OH, const float* s0, float* sout, int rowbase, int T, int h, int vg, LAS float* scr, int lane) {
    const int kq = lane & 31, g = lane >> 5, vcol = vg * 2 + g;
    f32x2 Sa, Sb;
    Sa[0] = s0 ? s0[(size_t)(kq * 4 + 0) * 128 + vcol] : 0.f; Sa[1] = s0 ? s0[(size_t)(kq * 4 + 1) * 128 + vcol] : 0.f;
    Sb[0] = s0 ? s0[(size_t)(kq * 4 + 2) * 128 + vcol] : 0.f; Sb[1] = s0 ? s0[(size_t)(kq * 4 + 3) * 128 + vcol] : 0.f;
    HgIn A[4], B[4];
    hg_load(A, Z, rowbase, 0, T, h, kq, vcol);
    for (int t0 = 0; t0 < T; t0 += BS) {
#pragma unroll 1
        for (int u = 0; u < BS; u += 8) {
            hg_load(B, Z, rowbase, t0 + u + 4, T, h, kq, vcol);
            hg_step4(A, Sa, Sb, scr, u, lane);
            hg_load(A, Z, rowbase, t0 + u + 8, T, h, kq, vcol);
            hg_step4(B, Sa, Sb, scr, u + 4, lane);
        }
        __builtin_amdgcn_wave_barrier(); LDS_WAIT();
        if (kq < BS) {
            float sum = 0.f;
#pragma unroll 8
            for (int i = 0; i < 32; ++i) sum += scr[kq * 64 + g * 32 + ((i + kq) & 31)];
            OH[(size_t)(rowbase + t0 + kq) * 512 + h * 128 + vcol] = sum;
        }
        __builtin_amdgcn_wave_barrier(); LDS_WAIT();
    }
    sout[(size_t)(kq * 4 + 0) * 128 + vcol] = Sa[0]; sout[(size_t)(kq * 4 + 1) * 128 + vcol] = Sa[1];
    sout[(size_t)(kq * 4 + 2) * 128 + vcol] = Sb[0]; sout[(size_t)(kq * 4 + 3) * 128 + vcol] = Sb[1];
}

typedef short bf16x8 __attribute__((ext_vector_type(8)));
typedef float f32x16 __attribute__((ext_vector_type(16)));
typedef float f32x2_t __attribute__((ext_vector_type(2))); typedef __bf16 bf16x2_t __attribute__((ext_vector_type(2)));
__device__ __forceinline__ unsigned cvtpk(float lo, float hi) { f32x2_t v = {lo, hi}; bf16x2_t b = __builtin_convertvector(v, bf16x2_t); return __builtin_bit_cast(unsigned, b); }
#define MFMA32(a, b, c) __builtin_amdgcn_mfma_f32_32x32x16_bf16((a), (b), (c), 0, 0, 0)
__device__ __forceinline__ void attn_unit(int u, const bf16* QB, const bf16* KB, const bf16* VB, bf16* OP, float* LSE, LAS unsigned char* vimg, int lane) {
    const int h = u & 7; int t = u >> 3; const int tile = t & 127; t >>= 7; const int p = t % 3, b = t / 3;
    const int sh = 2 * p, r = tile >> (7 - sh), qt = tile & ((128 >> sh) - 1);
    const int c = lane & 31, hi = lane >> 5;
    const int qrow = b * SEQ + ((32 * qt + c) << sh) + r;
    bf16x8 qf[4];
#pragma unroll
    for (int ks = 0; ks < 4; ++ks) qf[ks] = *(const bf16x8*)(QB + (size_t)qrow * 512 + h * 64 + ks * 16 + hi * 8);
    f32x16 o0, o1;
#pragma unroll
    for (int i = 0; i < 16; ++i) { o0[i] = 0.f; o1[i] = 0.f; }
    float m = -INFINITY, l = 0.f;
    const int pr = (c & 0x13) | ((c & 8) >> 1) | ((c & 4) << 1);
    const int kt0 = (qt >= 4) ? 0 : 4 - qt;
    const int kb0 = 32 * qt - 128;
    const bf16* kbase = KB + h * 64 + hi * 8; const bf16* vbase = VB + h * 64 + hi * 8;
    bf16x8 kf[2][4], vf[2][4];
#define ATT_LOAD(KT, BUF) do { const int kb_ = kb0 + 32 * (KT); const size_t kr_ = (size_t)(b * SEQ + ((kb_ + pr) << sh) + r) * 512, vr_ = (size_t)(b * SEQ + ((kb_ + c) << sh) + r) * 512; \
        _Pragma("unroll") for (int ks = 0; ks < 4; ++ks) kf[BUF][ks] = *(const bf16x8*)(kbase + kr_ + ks * 16); \
        _Pragma("unroll") for (int ks = 0; ks < 4; ++ks) vf[BUF][ks] = *(const bf16x8*)(vbase + vr_ + ks * 16); } while (0)
#pragma unroll
    for (int kt = 0; kt < 5; ++kt) {
        if (kt == kt0) ATT_LOAD(kt, kt & 1);
        if (kt >= kt0) {
            if (kt < 4) ATT_LOAD(kt + 1, (kt + 1) & 1);
            f32x16 s;
#pragma unroll
            for (int i = 0; i < 16; ++i) s[i] = 0.f;
#pragma unroll
            for (int ks = 0; ks < 4; ++ks) s = MFMA32(kf[kt & 1][ks], qf[ks], s);
#pragma unroll
            for (int ks = 0; ks < 4; ++ks)
#pragma unroll
                for (int e = 0; e < 8; ++e) *(LAS short*)(vimg + (ks * 16 + hi * 8 + e) * 80 + c * 2) = vf[kt & 1][ks][e];
            if (kt == 0) {
#pragma unroll
                for (int i = 0; i < 16; ++i) { const int ko = 16 * (i >> 3) + 8 * hi + (i & 7); s[i] = (ko >= c) ? s[i] : -INFINITY; }
            } else if (kt == 4) {
#pragma unroll
                for (int i = 0; i < 16; ++i) { const int ko = 16 * (i >> 3) + 8 * hi + (i & 7); s[i] = (ko <= c) ? s[i] : -INFINITY; }
            }
            float tmax = s[0];
#pragma unroll
            for (int i = 1; i < 16; ++i) tmax = fmaxf(tmax, s[i]);
            tmax = fmaxf(tmax, __shfl_xor(tmax, 32));
            const float mn = fmaxf(m, tmax), alpha = __expf(m - mn);
            float ls = 0.f;
#pragma unroll
            for (int i = 0; i < 16; ++i) { s[i] = __expf(s[i] - mn); ls += s[i]; }
            ls += __shfl_xor(ls, 32);
            l = l * alpha + ls; m = mn;
#pragma unroll
            for (int i = 0; i < 16; ++i) { o0[i] *= alpha; o1[i] *= alpha; }
            bf16x8 pf[2];
#pragma unroll
            for (int s2 = 0; s2 < 2; ++s2) { v4u w; w.x = cvtpk(s[8 * s2 + 0], s[8 * s2 + 1]); w.y = cvtpk(s[8 * s2 + 2], s[8 * s2 + 3]); w.z = cvtpk(s[8 * s2 + 4], s[8 * s2 + 5]); w.w = cvtpk(s[8 * s2 + 6], s[8 * s2 + 7]);
                pf[s2] = __builtin_bit_cast(bf16x8, w); }
            __builtin_amdgcn_wave_barrier(); LDS_WAIT();
#pragma unroll
            for (int s2 = 0; s2 < 2; ++s2) {
                const bf16x8 a0 = *(const LAS bf16x8*)(vimg + c * 80 + (16 * s2 + 8 * hi) * 2);
                const bf16x8 a1 = *(const LAS bf16x8*)(vimg + (32 + c) * 80 + (16 * s2 + 8 * hi) * 2);
                o0 = MFMA32(a0, pf[s2], o0); o1 = MFMA32(a1, pf[s2], o1);
            }
            __builtin_amdgcn_wave_barrier(); LDS_WAIT();
        }
    }
#undef ATT_LOAD
    const float inv = 1.f / l;
    bf16* orow = OP + ((size_t)p * M + qrow) * 512 + h * 64;
#pragma unroll
    for (int gq = 0; gq < 4; ++gq) {
        unsigned long long w0 = (unsigned long long)cvtpk(o0[4 * gq] * inv, o0[4 * gq + 1] * inv) | ((unsigned long long)cvtpk(o0[4 * gq + 2] * inv, o0[4 * gq + 3] * inv) << 32);
        unsigned long long w1 = (unsigned long long)cvtpk(o1[4 * gq] * inv, o1[4 * gq + 1] * inv) | ((unsigned long long)cvtpk(o1[4 * gq + 2] * inv, o1[4 * gq + 3] * inv) << 32);
        *(unsigned long long*)(orow + 8 * gq + 4 * hi) = w0;
        *(unsigned long long*)(orow + 32 + 8 * gq + 4 * hi) = w1;
    }
    if (hi == 0) LSE[((size_t)p * M + qrow) * 8 + h] = m + __logf(l);
}

__device__ __forceinline__ const float* skv_ptr(int b, int idx, int h, int seg, const float* Z, const float* cache, int l) {
    if (idx >= 2048) return Z + (size_t)(MP + b * 8 + (idx - 2048)) * NIN + seg + h * 64;
    return cache + ((((size_t)l * 32 + b) * 2048 + idx) * 8 + h) * 64;
}
__device__ __forceinline__ v4u aent(float c, const float* p) { v4u e; e.x = __builtin_bit_cast(unsigned, c); e.y = 0u; const unsigned long long a = (unsigned long long)p; e.z = (unsigned)a; e.w = (unsigned)(a >> 32); return e; }
__device__ __forceinline__ float dot64(const f32x4 (&q)[16], const float* kp) {
    float a0 = 0.f, a1 = 0.f, a2 = 0.f, a3 = 0.f;
#pragma unroll
    for (int i = 0; i < 16; ++i) { const f32x4 k = *((const f32x4*)kp + i); a0 = fmaf(q[i][0], k[0], a0); a1 = fmaf(q[i][1], k[1], a1); a2 = fmaf(q[i][2], k[2], a2); a3 = fmaf(q[i][3], k[3], a3); }
    return (a0 + a1) + (a2 + a3);
}
__device__ __forceinline__ void attn_sample_item(int it, int l, const float* Z, const float* ck, const float* cv, bf16* OP, float* LSE, LAS v4u* scr, int lane) {
    const int p = it % 3, h = (it / 3) & 7, rs = it / 24, b = rs >> 3, pos = 2048 + (rs & 7), row = MP + rs, d = 1 << (2 * p);
    float s0, sa, sb;
    const int ia = pos - d * (1 + lane), ib = pos - d * (65 + lane);
    {
        const float* qp = Z + (size_t)row * NIN + SEG_Q + h * 64;
        f32x4 q[16];
#pragma unroll
        for (int i = 0; i < 16; ++i) q[i] = *((const f32x4*)qp + i);
        s0 = dot64(q, skv_ptr(b, pos, h, SEG_K, Z, ck, l));
        sa = dot64(q, skv_ptr(b, ia, h, SEG_K, Z, ck, l));
        sb = dot64(q, skv_ptr(b, ib, h, SEG_K, Z, ck, l));
    }
    const float m = fmaxf(s0, wave_max(fmaxf(sa, sb)));
    const float e0 = __expf(s0 - m), ea = __expf(sa - m), eb = __expf(sb - m);
    const float lsum = e0 + wave_sum(ea + eb), inv = 1.f / lsum;
    const float* vself = skv_ptr(b, pos, h, SEG_V, Z, cv, l);
    scr[1 + lane] = aent(ea * inv, skv_ptr(b, ia, h, SEG_V, Z, cv, l));
    scr[65 + lane] = aent(eb * inv, skv_ptr(b, ib, h, SEG_V, Z, cv, l));
    if (lane < 4) scr[lane == 0 ? 0 : 128 + lane] = aent(lane == 0 ? e0 * inv : 0.f, vself);
    __builtin_amdgcn_wave_barrier(); LDS_WAIT();
    const int ks = lane >> 4, c4 = (lane & 15) * 4;
    f32x4 acc = {0.f, 0.f, 0.f, 0.f};
#pragma unroll 11
    for (int i = 0; i < 33; ++i) { const v4u e = scr[4 * i + ks]; const float* vp = (const float*)(((unsigned long long)e.w << 32) | e.z);
        const f32x4 v = *(const f32x4*)(vp + c4); acc = acc + v * __builtin_bit_cast(float, e.x); }
#pragma unroll
    for (int i = 0; i < 4; ++i) { acc[i] += __shfl_xor(acc[i], 16); acc[i] += __shfl_xor(acc[i], 32); }
    if (lane < 16) *(unsigned long long*)(OP + ((size_t)p * M + row) * 512 + h * 64 + c4) = (unsigned long long)cvtpk(acc[0], acc[1]) | ((unsigned long long)cvtpk(acc[2], acc[3]) << 32);
    if (lane == 0) LSE[((size_t)p * M + row) * 8 + h] = m + __logf(lsum);
    __builtin_amdgcn_wave_barrier(); LDS_WAIT();
}

__device__ __forceinline__ void hg_pass_a(int unit, const float* Z, float* U, float* DEC, LAS unsigned char* img, int lane) {
    const int kh = unit & 1, vh = (unit >> 1) & 1, cg = unit >> 2, c = cg & 63, seq = cg >> 6, h = seq & 3, b = seq >> 2;
    const size_t rowbase = (size_t)b * SEQ + c * 64;
    const float* zf = Z + rowbase * NIN + SEG_BF + h * 128 + kh * 64 + lane;
    const float* zv = Z + rowbase * NIN + SEG_BI + h * 128 + vh * 64 + lane;
    LAS unsigned char* imk = img; LAS unsigned char* imv = img + 9216;
    {
        float fv[64]; float tot = 0.f;
#pragma unroll
        for (int t = 0; t < 64; ++t) { fv[t] = zf[(size_t)t * NIN]; }
#pragma unroll
        for (int t = 0; t < 64; ++t) tot += __logf(fv[t]);
        float g = 0.f;
#pragma unroll
        for (int t8 = 0; t8 < 8; ++t8) {
            float kk[8];
#pragma unroll
            for (int j = 0; j < 8; ++j) { const float f = fv[t8 * 8 + j]; g += __logf(f); kk[j] = (1.f - f) * __expf(tot - g); }
            v4u w; w.x = cvtpk(kk[0], kk[1]); w.y = cvtpk(kk[2], kk[3]); w.z = cvtpk(kk[4], kk[5]); w.w = cvtpk(kk[6], kk[7]);
            *(LAS v4u*)(imk + lane * 144 + t8 * 16) = w;
        }
        if (vh == 0) DEC[(size_t)cg * 128 + kh * 64 + lane] = __expf(tot);
    }
    {
#pragma unroll
        for (int t8 = 0; t8 < 8; ++t8) {
            float vv[8];
#pragma unroll
            for (int j = 0; j < 8; ++j) vv[j] = zv[(size_t)(t8 * 8 + j) * NIN];
            v4u w; w.x = cvtpk(vv[0], vv[1]); w.y = cvtpk(vv[2], vv[3]); w.z = cvtpk(vv[4], vv[5]); w.w = cvtpk(vv[6], vv[7]);
            *(LAS v4u*)(imv + lane * 144 + t8 * 16) = w;
        }
    }
    __builtin_amdgcn_wave_barrier(); LDS_WAIT();
    const int cc = lane & 31, hi = lane >> 5;
#pragma unroll
    for (int vt = 0; vt < 2; ++vt)
#pragma unroll
        for (int kt = 0; kt < 2; ++kt) {
            f32x16 acc;
#pragma unroll
            for (int i = 0; i < 16; ++i) acc[i] = 0.f;
#pragma unroll
            for (int ts = 0; ts < 4; ++ts) {
                const bf16x8 a = *(const LAS bf16x8*)(imv + (vt * 32 + cc) * 144 + (16 * ts + 8 * hi) * 2);
                const bf16x8 bb = *(const LAS bf16x8*)(imk + (kt * 32 + cc) * 144 + (16 * ts + 8 * hi) * 2);
                acc = MFMA32(a, bb, acc);
            }
            float* up = U + ((size_t)cg * 128 + vh * 64 + vt * 32) * 128 + kh * 64 + kt * 32 + cc;
#pragma unroll
            for (int i = 0; i < 16; ++i) up[(size_t)((i & 3) + 8 * (i >> 2) + 4 * hi) * 128] = acc[i];
        }
    __builtin_amdgcn_wave_barrier(); LDS_WAIT();
}
__device__ __forceinline__ void hg_pass_b(const float* __restrict__ U, const float* __restrict__ DEC, bf16* __restrict__ SPREV, float* __restrict__ sfin, int gtid, int nthr) {
    for (int e = gtid * 2; e < 16 * 16384; e += nthr * 2) {
        const int seq = e >> 14, v = (e >> 7) & 127, k = e & 127;
        f32x2 S = {0.f, 0.f};
        const size_t eo = (size_t)v * 128 + k;
#pragma unroll 8
        for (int c = 0; c < 64; ++c) {
            const size_t cg = (size_t)seq * 64 + c;
            const f32x2 u = *(const f32x2*)(U + cg * 16384 + eo), dd = *(const f32x2*)(DEC + cg * 128 + k);
            *(unsigned*)(SPREV + cg * 16384 + eo) = cvtpk(S[0], S[1]);
            S = dd * S + u;
        }
        sfin[(size_t)seq * 16384 + (size_t)k * 128 + v] = S[0];
        sfin[(size_t)seq * 16384 + (size_t)(k + 1) * 128 + v] = S[1];
    }
}
constexpr int PC_QT = 0, PC_Q1 = 17408, PC_K0 = 26112, PC_K1 = 34816, PC_VT = 52224, PC_AM = 70656, PC_PRE = 79872, PC_RED = 81920;
__device__ __forceinline__ float exp_c(float x) { return __expf(fminf(x, 80.f)); }
__device__ __forceinline__ void hg_pass_c(int cg, const float* Z, const bf16* SPREV, const float* hgrn_g, bf16* O, LAS unsigned char* lds, int tid) {
    const int c = cg & 63, seq = cg >> 6, h = seq & 3, b = seq >> 2;
    const size_t rowbase = (size_t)b * SEQ + c * 64;
    const int kd = tid & 127, tq = tid >> 7, lane = tid & 63, wave = tid >> 6, cc = lane & 31, hi = lane >> 5;
    LAS float* PRE = (LAS float*)(lds + PC_PRE); LAS float* RED = (LAS float*)(lds + PC_RED);
    {
        const float* zr = Z + (rowbase + tq * 16) * NIN + h * 128 + kd;
        float fv[16], cs[16]; float run = 0.f;
#pragma unroll
        for (int j = 0; j < 16; ++j) fv[j] = zr[(size_t)j * NIN + SEG_BF];
#pragma unroll
        for (int j = 0; j < 16; ++j) { run += __logf(fv[j]); cs[j] = run; }
        PRE[tq * 128 + kd] = run;
        {
            float vv[16];
#pragma unroll
            for (int j = 0; j < 16; ++j) vv[j] = zr[(size_t)j * NIN + SEG_BI];
            v4u w0, w1; w0.x = cvtpk(vv[0], vv[1]); w0.y = cvtpk(vv[2], vv[3]); w0.z = cvtpk(vv[4], vv[5]); w0.w = cvtpk(vv[6], vv[7]);
            w1.x = cvtpk(vv[8], vv[9]); w1.y = cvtpk(vv[10], vv[11]); w1.z = cvtpk(vv[12], vv[13]); w1.w = cvtpk(vv[14], vv[15]);
            *(LAS v4u*)(lds + PC_VT + kd * 144 + tq * 32) = w0; *(LAS v4u*)(lds + PC_VT + kd * 144 + tq * 32 + 16) = w1;
        }
        __syncthreads();
        const float p0 = PRE[kd], p1 = PRE[128 + kd], p2 = PRE[256 + kd];
        const float pre = (tq > 0 ? p0 : 0.f) + (tq > 1 ? p1 : 0.f) + (tq > 2 ? p2 : 0.f);
        const float g31 = p0 + p1;
#pragma unroll
        for (int j = 0; j < 16; ++j) {
            const int t = tq * 16 + j;
            const float g = pre + cs[j], q = zr[(size_t)j * NIN + SEG_BQ], kk = 1.f - fv[j];
            *(LAS unsigned short*)(lds + PC_QT + t * 272 + kd * 2) = (unsigned short)cvtpk(q * __expf(g), 0.f);
            *(LAS unsigned short*)(lds + PC_K1 + t * 272 + kd * 2) = (unsigned short)cvtpk(kk * exp_c(g31 - g), 0.f);
            if (tq >= 2) *(LAS unsigned short*)(lds + PC_Q1 + (t - 32) * 272 + kd * 2) = (unsigned short)cvtpk(q * __expf(g - g31), 0.f);
            else         *(LAS unsigned short*)(lds + PC_K0 + t * 272 + kd * 2) = (unsigned short)cvtpk(kk * exp_c(-g), 0.f);
        }
    }
    __syncthreads();
    if (wave < 3) {
        const int st = (wave == 2) ? 1 : 0, tt = (wave == 0) ? 0 : 1;
        LAS unsigned char* kim = lds + (wave == 0 ? PC_K0 : PC_K1) + (wave == 2 ? 32 * 272 : 0);
        LAS unsigned char* qim = lds + (wave == 0 ? PC_QT : PC_Q1);
        f32x16 acc;
#pragma unroll
        for (int i = 0; i < 16; ++i) acc[i] = 0.f;
#pragma unroll
        for (int ks = 0; ks < 8; ++ks) {
            const bf16x8 a = *(const LAS bf16x8*)(kim + cc * 272 + (16 * ks + 8 * hi) * 2);
            const bf16x8 bq = *(const LAS bf16x8*)(qim + cc * 272 + (16 * ks + 8 * hi) * 2);
            acc = MFMA32(a, bq, acc);
        }
        if (wave != 1) {
#pragma unroll
            for (int i = 0; i < 16; ++i) { const int sl = (i & 3) + 8 * (i >> 2) + 4 * hi; acc[i] = (sl <= cc) ? acc[i] : 0.f; }
        }
#pragma unroll
        for (int gq = 0; gq < 4; ++gq)
            *(LAS unsigned long long*)(lds + PC_AM + (tt * 32 + cc) * 144 + (st * 32 + 8 * gq + 4 * hi) * 2) =
                (unsigned long long)cvtpk(acc[4 * gq], acc[4 * gq + 1]) | ((unsigned long long)cvtpk(acc[4 * gq + 2], acc[4 * gq + 3]) << 32);
    }
    __syncthreads();
    {
        const int vt = wave >> 1, tt = wave & 1;
        f32x16 acc;
#pragma unroll
        for (int i = 0; i < 16; ++i) acc[i] = 0.f;
        const bf16* sp = SPREV + (size_t)cg * 16384 + (size_t)(vt * 32 + cc) * 128 + 8 * hi;
#pragma unroll
        for (int ks = 0; ks < 8; ++ks) {
            const bf16x8 a = *(const bf16x8*)(sp + 16 * ks);
            const bf16x8 bq = *(const LAS bf16x8*)(lds + PC_QT + (tt * 32 + cc) * 272 + (16 * ks + 8 * hi) * 2);
            acc = MFMA32(a, bq, acc);
        }
#pragma unroll
        for (int ss = 0; ss < 4; ++ss) {
            if (ss < 2 || tt == 1) {
                const bf16x8 a = *(const LAS bf16x8*)(lds + PC_VT + (vt * 32 + cc) * 144 + (16 * ss + 8 * hi) * 2);
                const bf16x8 ba = *(const LAS bf16x8*)(lds + PC_AM + (tt * 32 + cc) * 144 + (16 * ss + 8 * hi) * 2);
                acc = MFMA32(a, ba, acc);
            }
        }
        float ssq = 0.f;
#pragma unroll
        for (int i = 0; i < 16; ++i) ssq += acc[i] * acc[i];
        ssq += __shfl_xor(ssq, 32);
        if (hi == 0) RED[vt * 64 + tt * 32 + cc] = ssq;
        __syncthreads();
        const int t = tt * 32 + cc;
        const float rstd = rsqrtf((RED[t] + RED[64 + t] + RED[128 + t] + RED[192 + t]) * (1.f / 128.f) + EPS);
        const size_t row = rowbase + t;
#pragma unroll
        for (int gq = 0; gq < 4; ++gq) {
            const int v0 = vt * 32 + 8 * gq + 4 * hi;
            const f32x4 gate = *(const f32x4*)(Z + row * NIN + SEG_BG + h * 128 + v0), gg = *(const f32x4*)(hgrn_g + v0);
            const float x0 = acc[4 * gq] * rstd * gg[0] * gate[0], x1 = acc[4 * gq + 1] * rstd * gg[1] * gate[1], x2 = acc[4 * gq + 2] * rstd * gg[2] * gate[2], x3 = acc[4 * gq + 3] * rstd * gg[3] * gate[3];
            *(unsigned long long*)(O + row * D + 512 + h * 128 + v0) = (unsigned long long)cvtpk(x0, x1) | ((unsigned long long)cvtpk(x2, x3) << 32);
        }
    }
    __syncthreads();
}

template <int K>
__device__ __forceinline__ void small_gemm(const bf16* A, const bf16* Bt, float* Y, LAS unsigned char* lds, int bx, int G, int tid) {
    const int lane = tid & 63, wave = tid >> 6, cc = lane & 31, hi = lane >> 5;
    constexpr int NS = K / 16 / 8;
    for (int w = bx; w < 256; w += G) {
        const int rt = w >> 5, ct = w & 31;
        const bf16* ap = A + (size_t)(MP + rt * 32 + cc) * K + wave * NS * 16 + 8 * hi;
        const bf16* bp = Bt + (size_t)(ct * 32 + cc) * K + wave * NS * 16 + 8 * hi;
        f32x16 acc;
#pragma unroll
        for (int i = 0; i < 16; ++i) acc[i] = 0.f;
#pragma unroll
        for (int ks = 0; ks < NS; ++ks) {
            const bf16x8 a = *(const bf16x8*)(ap + 16 * ks), bb = *(const bf16x8*)(bp + 16 * ks);
            acc = MFMA32(a, bb, acc);
        }
        LAS float* red = (LAS float*)lds;
#pragma unroll
        for (int i = 0; i < 16; ++i) red[wave * 1024 + i * 64 + lane] = acc[i];
        __syncthreads();
#pragma unroll
        for (int e2 = 0; e2 < 2; ++e2) {
            const int ei = tid + 512 * e2; float sum = 0.f;
#pragma unroll
            for (int ww = 0; ww < 8; ++ww) sum += red[ww * 1024 + ei];
            const int i = ei >> 6, ln = ei & 63, row = (i & 3) + 8 * (i >> 2) + 4 * (ln >> 5), col = ln & 31;
            Y[(size_t)(MP + rt * 32 + row) * D + ct * 32 + col] = sum;
        }
        __syncthreads();
    }
}

#define XB_TMO      128
#define XB_XCNT(j)  (256  + 64 * (j))
#define XB_XSUB(j)  (1280 + 64 * (j))
#define XB_XGEN(j)  (2304 + 64 * (j))
#define XB_TOP      3328
#define XB_TOPGEN   3392
#define XCD_BAR_WORDS 3456
#define XB_SPIN_CAP (1u << 18)

__device__ __forceinline__ unsigned xb_ld(unsigned* p)              { return __hip_atomic_load(p, __ATOMIC_RELAXED, __HIP_MEMORY_SCOPE_AGENT); }
__device__ __forceinline__ unsigned xb_add(unsigned* p, unsigned v) { return __hip_atomic_fetch_add(p, v, __ATOMIC_RELAXED, __HIP_MEMORY_SCOPE_AGENT); }
__device__ __forceinline__ unsigned xb_xcc_id() { return (unsigned)__builtin_amdgcn_s_getreg((3 << 11) | 20) & 0xFu; }
#define XB_SPIN(cond, bar) do { unsigned _sp = 0; while (cond) { __builtin_amdgcn_s_sleep(1); \
    if ((++_sp & 255u) == 0u) { if (xb_ld(&(bar)[XB_TMO])) break; if (_sp > XB_SPIN_CAP) { atomicAdd(&(bar)[XB_TMO], 1u); break; } } } } while (0)

struct XcdBarrier {
    unsigned* bar; unsigned x;
    volatile LAS unsigned* st;
};

__device__ __forceinline__ XcdBarrier xcd_barrier_post(unsigned* bar, volatile LAS unsigned* st) {
    XcdBarrier b; b.bar = bar; b.x = xb_xcc_id(); b.st = st;
    if (threadIdx.x == 0) (void)xb_add(&bar[XB_XCNT(b.x)], 1u);
    return b;
}
__device__ __forceinline__ void xcd_barrier_complete(unsigned* bar, unsigned x, unsigned& nloc, unsigned& nx) {
    const unsigned G = gridDim.x * gridDim.y * gridDim.z;
    unsigned sum, cnt, mine, sp = 0u;
    for (;;) {
        sum = 0u; cnt = 0u; mine = 0u;
#pragma unroll
        for (unsigned j = 0; j < 16; ++j) { const unsigned c = xb_ld(&bar[XB_XCNT(j)]); sum += c; cnt += (c > 0u) ? 1u : 0u; mine = (j == x) ? c : mine; }
        if (sum == G) break;
        __builtin_amdgcn_s_sleep(1);
        if ((++sp & 255u) == 0u) { if (xb_ld(&bar[XB_TMO])) break; if (sp > XB_SPIN_CAP) { atomicAdd(&bar[XB_TMO], 1u); break; } }
    }
    nloc = mine > 0u ? mine : 1u; nx = cnt > 0u ? cnt : 1u;
}

__device__ __forceinline__ void xcd_barrier(const XcdBarrier& b) {
    asm volatile("s_waitcnt vmcnt(0)" ::: "memory");
    __syncthreads();
    if (threadIdx.x == 0) {
        unsigned* bar = b.bar;
        __builtin_amdgcn_s_waitcnt(0);
        unsigned nloc = b.st[0], nx = b.st[1];
        if (nloc == 0u) { xcd_barrier_complete(bar, b.x, nloc, nx); b.st[0] = nloc; b.st[1] = nx; }
        const unsigned old = xb_add(&bar[XB_XSUB(b.x)], 1u);
        const unsigned gen = old / nloc;
        if (old + 1u == (gen + 1u) * nloc) {
            __builtin_amdgcn_fence(__ATOMIC_RELEASE, "agent");
            asm volatile("s_waitcnt vmcnt(0)" ::: "memory");
            const unsigned og = xb_add(&bar[XB_TOP], 1u);
            const unsigned tg = og / nx;
            if (og + 1u == (tg + 1u) * nx) xb_add(&bar[XB_TOPGEN], 1u);
            else XB_SPIN(xb_ld(&bar[XB_TOPGEN]) == tg, bar);
            __builtin_amdgcn_fence(__ATOMIC_ACQUIRE, "agent");
            xb_add(&bar[XB_XGEN(b.x)], 1u);
            asm volatile("s_waitcnt vmcnt(0)" ::: "memory");
        } else {
            XB_SPIN(xb_ld(&bar[XB_XGEN(b.x)]) == gen, bar);
            __builtin_amdgcn_fence(__ATOMIC_ACQUIRE, "agent");
            asm volatile("s_waitcnt vmcnt(0)" ::: "memory");
        }
    }
    __syncthreads();
}

struct Args { const float* in[22]; float* out; unsigned char* ws; int ph_lo, ph_hi; };
constexpr int N_PHASES = 25;

__global__ void __launch_bounds__(NWAVES * 64, 2) mk_fwd(Args args) {
    extern __shared__ __attribute__((aligned(16))) unsigned char lds_raw[];
    LAS unsigned char* lds = (LAS unsigned char*)lds_raw;
    const int G = gridDim.x, bx = blockIdx.x, NGW = G * NWAVES;
#define FRESH() int tid_ = threadIdx.x; asm volatile("" : "+v"(tid_)); const int tid = tid_, lane = tid & 63, wave = __builtin_amdgcn_readfirstlane(tid >> 6), gw = bx * NWAVES + wave; (void)tid; (void)lane; (void)gw;
    unsigned char* ws = args.ws;
    float* LB = (float*)(ws + WS_LB);
    bf16* Wb = (bf16*)(ws + WS_W);
    bf16* XN = (bf16*)(ws + WS_XN); bf16* OB = (bf16*)(ws + WS_O); bf16* HID = (bf16*)(ws + WS_HID);
    float* Y = (float*)(ws + WS_Y); float* HR = (float*)(ws + WS_H); float* Z = (float*)(ws + WS_Z);
    float* OH = (float*)(ws + WS_OH);
    bf16* QB = (bf16*)(ws + WS_QB); bf16* OPB = (bf16*)(ws + WS_OP); float* LSE = (float*)(ws + WS_LSE);
    float* UU = (float*)(ws + WS_U); float* DEC = (float*)(ws + WS_DEC); bf16* SPREV = (bf16*)(ws + WS_SPREV);
    float* out = args.out;
    const int lo = args.ph_lo, hi = args.ph_hi;
#define IN(k) (lo <= (k) && (k) < hi)
#define SEAM(k) do { if (IN(k) && IN((k) + 1)) { if ((k) == 0) cg::this_grid().sync(); else xcd_barrier(xbar); } } while (0)
    volatile LAS unsigned* MISC = (volatile LAS unsigned*)(lds + LDS_MISC);
    if (threadIdx.x < 2) MISC[threadIdx.x] = 0u;
    __syncthreads();
    XcdBarrier xbar = xcd_barrier_post((unsigned*)(ws + WS_BAR), MISC);

    if (IN(0)) {
        FRESH();
        LAS float* scr = (LAS float*)(lds + wave * 16384);
        constexpr int I_FF = (D / 64) * (FF / 32), I_DN = (FF / 64) * (D / 32), I_IN = (D / 64) * (NIN / 32), I_OUT = (D / 64) * (D / 32);
        constexpr int I_LAYER = 4 * I_FF + 2 * I_DN + I_IN + I_OUT;
        for (int it = gw; it < 2 * I_LAYER; it += NGW) {
            const int l = it / I_LAYER; int r = it % I_LAYER;
            bf16* wl = Wb + (size_t)l * W_LAYER;
            if (r < I_FF) { p0_transpose_item(args.in[6] + (size_t)l * D * FF, D, FF, wl + W_G1, 1, scr, r, lane); continue; } r -= I_FF;
            if (r < I_FF) { p0_transpose_item(args.in[7] + (size_t)l * D * FF, D, FF, wl + W_G1, 2, scr, r, lane); continue; } r -= I_FF;
            if (r < I_DN) { p0_transpose_item(args.in[8] + (size_t)l * D * FF, FF, D, wl + W_D1, 0, scr, r, lane); continue; } r -= I_DN;
            if (r < I_IN) { p0_transpose_item(args.in[11] + (size_t)l * D * NIN, D, NIN, wl + W_IN, 0, scr, r, lane); continue; } r -= I_IN;
            if (r < I_OUT) { p0_transpose_item(args.in[15] + (size_t)l * D * D, D, D, wl + W_OUT, 0, scr, r, lane); continue; } r -= I_OUT;
            if (r < I_FF) { p0_transpose_item(args.in[18] + (size_t)l * D * FF, D, FF, wl + W_G2, 1, scr, r, lane); continue; } r -= I_FF;
            if (r < I_FF) { p0_transpose_item(args.in[19] + (size_t)l * D * FF, D, FF, wl + W_G2, 2, scr, r, lane); continue; } r -= I_FF;
            p0_transpose_item(args.in[20] + (size_t)l * D * FF, FF, D, wl + W_D2, 0, scr, r, lane);
        }
        if (bx == 0) {
            const float* lg = args.in[13];
            const float x0 = lg[tid], x1 = lg[512 + tid];
            LB[tid] = 0.f; LB[512 + tid] = 1.f / (1.f + __expf(x0 - x1));
        }
        row_phase<false>(args.in[0], args.in[1], nullptr, nullptr, 0.f, nullptr, args.in[5], XN, gw, NGW, lane);
    }
    SEAM(0);

#pragma unroll 1
    for (int l = 0; l < 2; ++l) {
        const int pb = 1 + 12 * l;
        const bf16* wl = Wb + (size_t)l * W_LAYER;
        if (IN(pb + 0)) {
            pg8::Gemm g{XN, wl + W_G1, M, 2 * FF, D}; pg8::StaticOrder S; S.init(M, 2 * FF, G, bx);
            EpiSwiglu E{HID};
            pg8::gemm_phase<EpiSwiglu, pg8::StaticOrder, true, true>(lds, g, S, E);
        }
        SEAM(pb + 0);
        if (IN(pb + 1)) {
            { FRESH(); small_gemm<FF>(HID, wl + W_D1, Y, lds, bx, G, tid); }
            pg8::Gemm g{HID, wl + W_D1, MP, D, FF}; pg8::StaticOrder S; S.init(MP, D, G, bx);
            EpiF32 E{Y, D};
            pg8::gemm_phase<EpiF32, pg8::StaticOrder, true, true>(lds, g, S, E);
        }
        SEAM(pb + 1);
        if (IN(pb + 2)) {
            FRESH();
            if (l == 0) row_phase<true>(args.in[0], args.in[1], Y, args.in[9] + l * D, 0.5f, HR, args.in[10] + l * D, XN, gw, NGW, lane);
            else        row_phase<true>(HR, nullptr, Y, args.in[9] + l * D, 0.5f, HR, args.in[10] + l * D, XN, gw, NGW, lane);
        }
        SEAM(pb + 2);
        if (IN(pb + 3)) {
            pg8::Gemm g{XN, wl + W_IN, M, NIN, D}; pg8::StaticOrder S; S.init(M, NIN, G, bx);
            EpiMix E{Z, LB + l * 512, out, l, QB};
            pg8::gemm_phase<EpiMix, pg8::StaticOrder, true, true>(lds, g, S, E);
        }
        SEAM(pb + 3);
        if (IN(pb + 4)) {
            FRESH();
            LAS unsigned char* wl_ = lds + wave * WLDS;
            for (int u = gw; u < 4096; u += NGW) hg_pass_a(u, Z, UU, DEC, wl_, lane);
            {
                constexpr int NU = 4 * 3 * 128 * 8;
                const int per = (NU + NGW - 1) / NGW, u0 = gw * per, u1 = (u0 + per < NU) ? u0 + per : NU;
                for (int u = u0; u < u1; ++u) attn_unit(u, QB, QB + (size_t)MP * 512, QB + (size_t)2 * MP * 512, OPB, LSE, wl_, lane);
            }
            for (int it = gw; it < MS * 24; it += NGW) attn_sample_item(it, l, Z, args.in[2], args.in[3], OPB, LSE, (LAS v4u*)wl_, lane);
            for (int task = gw; task < 8192; task += NGW) {
                const int b = task >> 8, h = (task >> 6) & 3, vg = task & 63;
                const size_t so = ((size_t)(l * 32 + b) * 4 + h) * 16384;
                hgrn_task<8>(Z, OH, args.in[4] + so, out + OFF_SS + so, MP + b * 8, 8, h, vg, (LAS float*)wl_, lane);
            }
        }
        SEAM(pb + 4);
        if (IN(pb + 5)) { FRESH(); hg_pass_b(UU, DEC, SPREV, out + OFF_SP + (size_t)l * 16 * 16384, bx * (NWAVES * 64) + tid, G * NWAVES * 64); }
        SEAM(pb + 5);
        if (IN(pb + 6)) {
            FRESH();
            for (int cg = bx; cg < 1024; cg += G) hg_pass_c(cg, Z, SPREV, args.in[14] + l * 128, OB, lds, tid);
            r3_phase(OPB, LSE, OH, Z, args.in[12] + l * 512, args.in[14] + l * 128, OB, gw, NGW, lane);
        }
        SEAM(pb + 6);
        if (IN(pb + 7)) {
            { FRESH(); small_gemm<D>(OB, wl + W_OUT, Y, lds, bx, G, tid); }
            pg8::Gemm g{OB, wl + W_OUT, MP, D, D}; pg8::StaticOrder S; S.init(MP, D, G, bx);
            EpiF32 E{Y, D};
            pg8::gemm_phase<EpiF32, pg8::StaticOrder, true, true>(lds, g, S, E);
        }
        SEAM(pb + 7);
        if (IN(pb + 8)) { FRESH(); row_phase<true>(HR, nullptr, Y, args.in[16] + l * D, 1.0f, HR, args.in[17] + l * D, XN, gw, NGW, lane); }
        SEAM(pb + 8);
        if (IN(pb + 9)) {
            pg8::Gemm g{XN, wl + W_G2, M, 2 * FF, D}; pg8::StaticOrder S; S.init(M, 2 * FF, G, bx);
            EpiSwiglu E{HID};
            pg8::gemm_phase<EpiSwiglu, pg8::StaticOrder, true, true>(lds, g, S, E);
        }
        SEAM(pb + 9);
        if (IN(pb + 10)) {
            { FRESH(); small_gemm<FF>(HID, wl + W_D2, Y, lds, bx, G, tid); }
            pg8::Gemm g{HID, wl + W_D2, MP, D, FF}; pg8::StaticOrder S; S.init(MP, D, G, bx);
            EpiF32 E{Y, D};
            pg8::gemm_phase<EpiF32, pg8::StaticOrder, true, true>(lds, g, S, E);
        }
        SEAM(pb + 10);
        if (IN(pb + 11)) {
            FRESH();
            if (l == 0) row_phase<true>(HR, nullptr, Y, args.in[21] + l * D, 0.5f, HR, args.in[5] + D, XN, gw, NGW, lane);
            else        row_phase<true>(HR, nullptr, Y, args.in[21] + l * D, 0.5f, out + OFF_Y, nullptr, nullptr, gw, NGW, lane);
        }
        SEAM(pb + 11);
    }
#undef IN
#undef SEAM
}

extern "C" void kernel_launch(void* const* d_in, const int* in_sizes, int n_in, void* d_out, int out_size, void* d_ws, size_t ws_size, hipStream_t stream) {
    static int grid = 0;
    if (grid == 0) {
        if (n_in != 22 || ws_size < WS_END) { fprintf(stderr, "kernel_launch: n_in %d ws %zu (need %zu)\n", n_in, ws_size, (size_t)WS_END); grid = -1; return; }
        int dev = 0, cus = 0, per_cu = 0;
        (void)hipGetDevice(&dev);
        (void)hipDeviceGetAttribute(&cus, hipDeviceAttributeMultiprocessorCount, dev);
        if (hipFuncSetAttribute((const void*)mk_fwd, hipFuncAttributeMaxDynamicSharedMemorySize, LDS_BYTES) != hipSuccess) { fprintf(stderr, "kernel_launch: hipFuncSetAttribute failed\n"); grid = -1; return; }
        if (hipOccupancyMaxActiveBlocksPerMultiprocessor(&per_cu, (const void*)mk_fwd, NWAVES * 64, LDS_BYTES) != hipSuccess || per_cu < 1) { fprintf(stderr, "kernel_launch: occupancy query says %d\n", per_cu); per_cu = 1; }
        (void)hipGetLastError();
        grid = cus * (per_cu > 1 ? 1 : per_cu);
        fprintf(stderr, "kernel_launch: grid %d (cus %d per_cu %d)\n", grid, cus, per_cu);
    }
    if (grid < 0) return;
    if (hipMemsetAsync((char*)d_ws + WS_BAR, 0, 16384, stream) != hipSuccess) { fprintf(stderr, "kernel_launch: memset failed\n"); return; }
    Args a{};
    for (int i = 0; i < 22; ++i) a.in[i] = (const float*)d_in[i];
    a.out = (float*)d_out; a.ws = (unsigned char*)d_ws;
#if MK_MULTI
    for (int p = 0; p < N_PHASES; ++p) {
        a.ph_lo = p; a.ph_hi = p + 1;
        void* kargs[] = {&a};
        hipError_t e = hipLaunchCooperativeKernel((const void*)mk_fwd, dim3(grid), dim3(NWAVES * 64), kargs, LDS_BYTES, stream);
        if (e != hipSuccess) { fprintf(stderr, "kernel_launch: launch %d failed: %s\n", p, hipGetErrorString(e)); break; }
    }
#else
    a.ph_lo = 0; a.ph_hi = N_PHASES;
    void* kargs[] = {&a};
    hipError_t e = hipLaunchCooperativeKernel((const void*)mk_fwd, dim3(grid), dim3(NWAVES * 64), kargs, LDS_BYTES, stream);
    if (e != hipSuccess) fprintf(stderr, "kernel_launch: cooperative launch failed: %s (grid %d)\n", hipGetErrorString(e), grid);
#endif
}
```

```cpp
#include <hip/hip_runtime.h>
#include <hip/hip_cooperative_groups.h>
#include <cstdio>
#include <cstdint>
namespace cg = cooperative_groups;

#ifndef MK_MULTI
#define MK_MULTI 0
#endif

namespace pg8 {
#define PG8_LAS __attribute__((address_space(3)))
typedef unsigned short bf16_t;
typedef short bf16x8 __attribute__((ext_vector_type(8)));
typedef float f32x4 __attribute__((ext_vector_type(4)));
typedef unsigned u32x4 __attribute__((ext_vector_type(4)));
constexpr int BM = 256, BK = 64, HALF = 128, HTB = HALF * BK * 2  , STAGE_BYTES = 8 * HTB, NXCD = 8, WGM = 8;

__host__ __device__ __forceinline__ int lds_byte(int r, int c) { const int st = (r >> 4) * 2 + (c >> 5), rr = r & 15, cc = c & 31, ob = rr * 64 + cc * 2; return st * 1024 + (ob ^ (((ob >> 9) & 1) << 5)); }
__host__ __device__ __forceinline__ void stage_rc(int b, int& R, int& C) { const int st = b / 1024, sb = b % 1024, swz = sb ^ (((sb >> 9) & 1) << 5); R = (st >> 1) * 16 + swz / 64; C = (st & 1) * 32 + (swz % 64) / 2; }
__host__ __device__ __forceinline__ int perm32(int rho) { const int n = rho >> 4, i = rho & 15; return 8 * (i >> 2) + 4 * n + (i & 3); }

struct Unit { int pm, pn; };
struct Gemm { const bf16_t* A; const bf16_t* Bt; int M, N, K; };

struct StaticOrder {
    int nM, nN, nwg, G, c;
    __host__ __device__ void init(int M, int N, int G_, int c_) { nM = M / BM; nN = N / BM; nwg = nM * nN; G = G_; c = c_; }
    __host__ __device__ bool next(int i, Unit& u) const {
        const long L = (long)i * G + c; if (L >= nwg) return false;
        int wgid = (int)L; { const int q = nwg / NXCD, r = nwg % NXCD, xcd = wgid % NXCD, off = wgid / NXCD; wgid = (xcd < r ? xcd * (q + 1) : r * (q + 1) + (xcd - r) * q) + off; }
        const int nig = WGM * nN, gid = wgid / nig, fm = gid * WGM, gsz = (nM - fm) < WGM ? (nM - fm) : WGM;
        u.pm = fm + ((wgid % nig) % gsz); u.pn = (wgid % nig) / gsz; return true;
    }
    __device__ __forceinline__ void a_ready(const Unit&) const {}
    __device__ __forceinline__ void done(const Unit&) const {}
};

template <class Epi, class Sched, bool ALIGN_EPI = false, bool SP2 = false>
__device__ __forceinline__ void gemm_phase(PG8_LAS unsigned char* lds, const Gemm g, const Sched& S, const Epi& E) {
    int tid_ = threadIdx.x; asm volatile("" : "+v"(tid_));
    const int tid = tid_, wid = __builtin_amdgcn_readfirstlane(tid >> 6), lane = tid & 63, wr = wid >> 2, wc = wid & 3, fr = lane & 15, fq = lane >> 4;
    const int K = g.K, nt = K / BK;
    unsigned voffA[2], voffB[2];
#pragma unroll
    for (int i = 0; i < 2; ++i) { int R, C; stage_rc(tid * 16 + i * 8192, R, C); const int Rb = Epi::PERM ? ((R & ~31) + perm32(R & 31)) : R;
        voffA[i] = (unsigned)(R * K + C) * 2u; voffB[i] = (unsigned)(Rb * K + C) * 2u; }
    const size_t kstep = (size_t)(BK * 2);
    const size_t hstep = (size_t)HALF * K * 2;
    const size_t tstep = 2 * hstep;
    const unsigned ldsw = (unsigned)wid * 1024u;
    const int aoff = lds_byte(wr * 64 + fr, fq * 8), boff = lds_byte(wc * 32 + fr, fq * 8);
#define PG8_SA(b, h) (((b) * 2 + (h)) * HTB)
#define PG8_SB(b, h) ((4 + (b) * 2 + (h)) * HTB)
#define PG8_STAGE(bufoff, gbase, voff) do { _Pragma("unroll") for (int _i = 0; _i < 2; ++_i) \
        __builtin_amdgcn_global_load_lds((const unsigned*)((const char*)(gbase) + (voff)[_i]), (PG8_LAS unsigned*)(lds + (bufoff) + ldsw + _i * 8192), 16, 0, 0); } while (0)
#define PG8_LDA(dst, b, h) do { _Pragma("unroll") for (int m = 0; m < 4; ++m) _Pragma("unroll") for (int k = 0; k < 2; ++k) dst[m][k] = *(const PG8_LAS bf16x8*)(lds + PG8_SA(b, h) + aoff + m * 2048 + k * 1024); } while (0)
#define PG8_LDB(dst, b, h) do { _Pragma("unroll") for (int n = 0; n < 2; ++n) _Pragma("unroll") for (int k = 0; k < 2; ++k) dst[n][k] = *(const PG8_LAS bf16x8*)(lds + PG8_SB(b, h) + boff + n * 2048 + k * 1024); } while (0)
#define PG8_MMA(ai, bj, At, Bt) do { __builtin_amdgcn_s_setprio(1); _Pragma("unroll") for (int m = 0; m < 4; ++m) _Pragma("unroll") for (int n = 0; n < 2; ++n) _Pragma("unroll") for (int k = 0; k < 2; ++k) \
        acc[ai][bj][m][n] = __builtin_amdgcn_mfma_f32_16x16x32_bf16(Bt[n][k], At[m][k], acc[ai][bj][m][n], 0, 0, 0); __builtin_amdgcn_s_setprio(0); } while (0)
#define PG8_WAIT_V(n) asm volatile("s_waitcnt vmcnt(" #n ")" ::: "memory")
#define PG8_WAIT_L(n) asm volatile("s_waitcnt lgkmcnt(" #n ")" ::: "memory")
#define PG8_BAR __builtin_amdgcn_s_barrier()
#define PG8_SCHED __builtin_amdgcn_sched_barrier(0)
    Unit cur, nxt; int ui = 0;
    if (!S.next(0, cur)) return;
    f32x4 acc[2][2][4][2];
#pragma unroll
    for (int a = 0; a < 2; ++a)
#pragma unroll
        for (int b = 0; b < 2; ++b)
#pragma unroll
            for (int m = 0; m < 4; ++m)
#pragma unroll
                for (int n = 0; n < 2; ++n) acc[a][b][m][n] = (f32x4){0.f, 0.f, 0.f, 0.f};
    bf16x8 At[4][2], B0[2][2], B1[2][2];
    const char* cA = (const char*)g.A + (size_t)cur.pm * tstep; const char* cB = (const char*)g.Bt + (size_t)cur.pn * tstep;
    S.a_ready(cur);
    if constexpr (SP2) {
        PG8_STAGE(PG8_SB(0, 0), cB, voffB); PG8_STAGE(PG8_SB(0, 1), cB + hstep, voffB); PG8_STAGE(PG8_SA(0, 0), cA, voffA); PG8_STAGE(PG8_SA(0, 1), cA + hstep, voffA);
        if (wr == 1) PG8_BAR;
        PG8_WAIT_V(2); PG8_BAR;
        PG8_STAGE(PG8_SB(1, 0), cB + kstep, voffB); PG8_STAGE(PG8_SA(1, 0), cA + kstep, voffA); PG8_STAGE(PG8_SB(1, 1), cB + hstep + kstep, voffB);
        PG8_WAIT_V(6); PG8_BAR;
    } else {
        PG8_STAGE(PG8_SB(0, 0), cB, voffB); PG8_STAGE(PG8_SA(0, 0), cA, voffA); PG8_STAGE(PG8_SB(0, 1), cB + hstep, voffB); PG8_STAGE(PG8_SA(0, 1), cA + hstep, voffA);
        if (wr == 1) PG8_BAR;
        PG8_WAIT_V(4); PG8_BAR;
        PG8_STAGE(PG8_SB(1, 0), cB + kstep, voffB); PG8_STAGE(PG8_SA(1, 0), cA + kstep, voffA); PG8_STAGE(PG8_SB(1, 1), cB + hstep + kstep, voffB);
        PG8_WAIT_V(6); PG8_BAR;
    }
    for (;;) {
        const bool has_next = S.next(ui + 1, nxt);
        const char* nA = has_next ? (const char*)g.A + (size_t)nxt.pm * tstep : cA; const char* nB = has_next ? (const char*)g.Bt + (size_t)nxt.pn * tstep : cB;
        for (int t = 0; t < nt; t += 2) {
            const bool last = (t == nt - 2);
            const char* a1 = cA + (size_t)(t + 1) * kstep;
            const char* a2 = last ? nA : cA + (size_t)(t + 2) * kstep; const char* b2 = last ? nB : cB + (size_t)(t + 2) * kstep;
            const char* a3 = a2 + kstep; const char* b3 = b2 + kstep;
            if (last && has_next) S.a_ready(nxt);
            if constexpr (SP2) {
            PG8_LDB(B0, 0, 0); PG8_LDB(B1, 0, 1); PG8_SCHED; PG8_LDA(At, 0, 0); PG8_STAGE(PG8_SA(1, 1), a1 + hstep, voffA);
            PG8_WAIT_V(8); PG8_WAIT_L(0); PG8_BAR; PG8_MMA(0, 0, At, B0); PG8_MMA(0, 1, At, B1); PG8_BAR; PG8_SCHED;
            PG8_LDA(At, 0, 1); PG8_STAGE(PG8_SB(0, 0), b2, voffB); PG8_STAGE(PG8_SB(0, 1), b2 + hstep, voffB); PG8_STAGE(PG8_SA(0, 0), a2, voffA);
            PG8_WAIT_V(8); PG8_WAIT_L(0); PG8_BAR; PG8_MMA(1, 0, At, B0); PG8_MMA(1, 1, At, B1); PG8_BAR; PG8_SCHED;
            PG8_LDB(B0, 1, 0); PG8_LDB(B1, 1, 1); PG8_SCHED; PG8_LDA(At, 1, 0); PG8_STAGE(PG8_SA(0, 1), a2 + hstep, voffA);
            PG8_WAIT_V(8); PG8_WAIT_L(0); PG8_BAR; PG8_MMA(0, 0, At, B0); PG8_MMA(0, 1, At, B1); PG8_BAR; PG8_SCHED;
            PG8_LDA(At, 1, 1); PG8_STAGE(PG8_SB(1, 0), b3, voffB); PG8_STAGE(PG8_SB(1, 1), b3 + hstep, voffB); PG8_STAGE(PG8_SA(1, 0), a3, voffA);
            PG8_WAIT_V(8); PG8_WAIT_L(0); PG8_BAR; PG8_MMA(1, 0, At, B0); PG8_MMA(1, 1, At, B1); PG8_BAR; PG8_SCHED;
            } else {
            PG8_LDB(B0, 0, 0); PG8_SCHED; PG8_LDA(At, 0, 0); PG8_STAGE(PG8_SA(1, 1), a1 + hstep, voffA);
            PG8_WAIT_L(8); PG8_BAR; PG8_WAIT_L(0); PG8_MMA(0, 0, At, B0); PG8_BAR; PG8_SCHED;
            PG8_LDB(B1, 0, 1); PG8_STAGE(PG8_SB(0, 0), b2, voffB);
            PG8_BAR; PG8_WAIT_L(0); PG8_MMA(0, 1, At, B1); PG8_BAR;
            PG8_LDA(At, 0, 1); PG8_STAGE(PG8_SA(0, 0), a2, voffA);
            PG8_BAR; PG8_WAIT_L(0); PG8_MMA(1, 0, At, B0); PG8_BAR; PG8_SCHED;
            PG8_STAGE(PG8_SB(0, 1), b2 + hstep, voffB);
            PG8_WAIT_V(6); PG8_BAR; PG8_MMA(1, 1, At, B1); PG8_BAR;
            PG8_LDB(B0, 1, 0); PG8_SCHED; PG8_LDA(At, 1, 0); PG8_STAGE(PG8_SA(0, 1), a2 + hstep, voffA);
            PG8_WAIT_L(8); PG8_BAR; PG8_WAIT_L(0); PG8_MMA(0, 0, At, B0); PG8_BAR; PG8_SCHED;
            PG8_LDB(B1, 1, 1); PG8_STAGE(PG8_SB(1, 0), b3, voffB);
            PG8_BAR; PG8_WAIT_L(0); PG8_MMA(0, 1, At, B1); PG8_BAR;
            PG8_LDA(At, 1, 1); PG8_STAGE(PG8_SA(1, 0), a3, voffA);
            PG8_BAR; PG8_WAIT_L(0); PG8_MMA(1, 0, At, B0); PG8_BAR; PG8_SCHED;
            PG8_STAGE(PG8_SB(1, 1), b3 + hstep, voffB);
            PG8_WAIT_V(6); PG8_BAR; PG8_MMA(1, 1, At, B1); PG8_BAR;
            }
        }
        if constexpr (ALIGN_EPI) { if (wr == 0) PG8_BAR; }
        if constexpr (!Epi::AFTER_DRAIN) { E(acc, cur, wr, wc, fr, fq); S.done(cur); }
        if (!has_next) break;
#pragma unroll
        for (int a = 0; a < 2; ++a)
#pragma unroll
            for (int b = 0; b < 2; ++b)
#pragma unroll
                for (int m = 0; m < 4; ++m)
#pragma unroll
                    for (int n = 0; n < 2; ++n) acc[a][b][m][n] = (f32x4){0.f, 0.f, 0.f, 0.f};
        cur = nxt; cA = nA; cB = nB; ++ui;
        if constexpr (ALIGN_EPI) { if (wr == 1) PG8_BAR; }
    }
    PG8_WAIT_V(0);
    if constexpr (!ALIGN_EPI) { if (wr == 0) PG8_BAR; }
    PG8_BAR;
    if constexpr (Epi::AFTER_DRAIN) { E.fused(acc, cur, wr, wc, fr, fq, lds, wid, lane); S.done(cur); }
#undef PG8_SA
#undef PG8_SB
#undef PG8_STAGE
#undef PG8_LDA
#undef PG8_LDB
#undef PG8_MMA
#undef PG8_WAIT_V
#undef PG8_WAIT_L
#undef PG8_BAR
#undef PG8_SCHED
}
}

constexpr int NWAVES = 8;
constexpr int D = 1024, FF = 2816, NIN = 3584, MP = 16384, MS = 256, M = MP + MS, SEQ = 4096;
constexpr int SEG_Q = 0, SEG_K = 512, SEG_V = 1024, SEG_BQ = 1536, SEG_BF = 2048, SEG_BI = 2560, SEG_BG = 3072;
constexpr float EPS = 1e-6f;
constexpr size_t OFF_Y = 0, OFF_KP = 17039360, OFF_VP = 25427968, OFF_SP = 33816576, OFF_KS = 34340864, OFF_VS = 34603008, OFF_SS = 34865152;
constexpr size_t MiB = 1u << 20;
constexpr size_t WS_LB = 0;
constexpr size_t WS_BAR = 65536;
constexpr size_t WS_W = 1 * MiB;
constexpr size_t W_G1 = 0, W_D1 = W_G1 + (size_t)2 * FF * D, W_IN = W_D1 + (size_t)D * FF, W_OUT = W_IN + (size_t)NIN * D,
                 W_G2 = W_OUT + (size_t)D * D, W_D2 = W_G2 + (size_t)2 * FF * D, W_LAYER = W_D2 + (size_t)D * FF;
constexpr size_t WS_XN = WS_W + 2 * W_LAYER * 2;
constexpr size_t WS_O = WS_XN + (size_t)M * D * 2;
constexpr size_t WS_HID = WS_O + (size_t)M * D * 2;
constexpr size_t WS_Y = WS_HID + (size_t)M * FF * 2;
constexpr size_t WS_H = WS_Y + (size_t)M * D * 4;
constexpr size_t WS_Z = WS_H + (size_t)M * D * 4;
constexpr size_t WS_OA = WS_Z + (size_t)M * NIN * 4;
constexpr size_t WS_OH = WS_OA + (size_t)M * 512 * 4;
constexpr size_t WS_QB = WS_OH + (size_t)M * 512 * 4;
constexpr size_t WS_KB = WS_QB + (size_t)MP * 512 * 2;
constexpr size_t WS_VB = WS_KB + (size_t)MP * 512 * 2;
constexpr size_t WS_OP = WS_VB + (size_t)MP * 512 * 2;
constexpr size_t WS_LSE = WS_OP + (size_t)3 * M * 512 * 2;
constexpr size_t WS_U = WS_LSE + (size_t)3 * M * 8 * 4;
constexpr size_t WS_DEC = WS_U + (size_t)1024 * 16384 * 4;
constexpr size_t WS_SPREV = WS_DEC + (size_t)1024 * 128 * 4;
constexpr size_t WS_END = WS_SPREV + (size_t)1024 * 16384 * 2;
constexpr int LDS_BYTES = 147456 + 256, LDS_MISC = 147456, WLDS = 18432;

#define GAS __attribute__((address_space(1)))
#define LAS __attribute__((address_space(3)))
typedef unsigned short bf16;
typedef unsigned v4u __attribute__((ext_vector_type(4)));
typedef float f32x4 __attribute__((ext_vector_type(4)));
#define LDS_WAIT() asm volatile("s_waitcnt lgkmcnt(0)" ::: "memory")

__device__ __forceinline__ unsigned f2bf(float f) { unsigned u = __builtin_bit_cast(unsigned, f); return (u + 0x7fffu + ((u >> 16) & 1u)) >> 16; }
__device__ __forceinline__ unsigned pk2(float lo, float hi) { return f2bf(lo) | (f2bf(hi) << 16); }
__device__ __forceinline__ float silu_f(float x) { return x * __frcp_rn(1.f + __expf(-x)); }
__device__ __forceinline__ float sigmoid_f(float x) { return __frcp_rn(1.f + __expf(-x)); }
__device__ __forceinline__ float wave_sum(float v) {
#pragma unroll
    for (int o = 1; o < 64; o <<= 1) v += __shfl_xor(v, o);
    return v;
}
__device__ __forceinline__ float wave_max(float v) {
#pragma unroll
    for (int o = 1; o < 64; o <<= 1) v = fmaxf(v, __shfl_xor(v, o));
    return v;
}

struct EpiSwiglu {
    static constexpr bool PERM = true, AFTER_DRAIN = false;
    bf16* H;
    __device__ __forceinline__ void operator()(const pg8::f32x4 (&acc)[2][2][4][2], const pg8::Unit& u, int wr, int wc, int fr, int fq) const {
        const int row0 = u.pm * 256 + wr * 64 + fr, col0 = u.pn * 128 + wc * 32 + 8 * fq;
#pragma unroll
        for (int ai = 0; ai < 2; ++ai)
#pragma unroll
            for (int m = 0; m < 4; ++m) {
                bf16* rowp = H + (size_t)(row0 + ai * 128 + m * 16) * FF + col0;
                const pg8::f32x4 g0 = acc[ai][0][m][0], g1 = acc[ai][0][m][1], u0 = acc[ai][1][m][0], u1 = acc[ai][1][m][1];
                v4u w;
                w.x = pk2(silu_f(g0[0]) * u0[0], silu_f(g0[1]) * u0[1]); w.y = pk2(silu_f(g0[2]) * u0[2], silu_f(g0[3]) * u0[3]);
                w.z = pk2(silu_f(g1[0]) * u1[0], silu_f(g1[1]) * u1[1]); w.w = pk2(silu_f(g1[2]) * u1[2], silu_f(g1[3]) * u1[3]);
                *(v4u*)rowp = w;
            }
    }
};
struct EpiF32 {
    static constexpr bool PERM = true, AFTER_DRAIN = false;
    float* Y; int ldc;
    __device__ __forceinline__ void operator()(const pg8::f32x4 (&acc)[2][2][4][2], const pg8::Unit& u, int wr, int wc, int fr, int fq) const {
        const int row0 = u.pm * 256 + wr * 64 + fr, col0 = u.pn * 256 + wc * 32 + 8 * fq;
#pragma unroll
        for (int ai = 0; ai < 2; ++ai)
#pragma unroll
            for (int m = 0; m < 4; ++m) {
                float* rowp = Y + (size_t)(row0 + ai * 128 + m * 16) * ldc + col0;
#pragma unroll
                for (int bj = 0; bj < 2; ++bj)
#pragma unroll
                    for (int n = 0; n < 2; ++n) *(f32x4*)(rowp + bj * 128 + 4 * n) = acc[ai][bj][m][n];
            }
    }
};
struct EpiMix {
    static constexpr bool PERM = true, AFTER_DRAIN = false;
    float* Z; const float* lb; float* out; int l; bf16* QKV;
    __device__ __forceinline__ void operator()(const pg8::f32x4 (&acc)[2][2][4][2], const pg8::Unit& u, int wr, int wc, int fr, int fq) const {
        const int seg = u.pn >> 1;
        const int row0 = u.pm * 256 + wr * 64 + fr, cs0 = (u.pn & 1) * 256 + wc * 32 + 8 * fq;
        f32x4 lbv[2][2];
#pragma unroll
        for (int bj = 0; bj < 2; ++bj)
#pragma unroll
            for (int n = 0; n < 2; ++n) lbv[bj][n] = (seg == 4) ? *(const f32x4*)(lb + cs0 + bj * 128 + 4 * n) : (f32x4){0.f, 0.f, 0.f, 0.f};
#pragma unroll
        for (int ai = 0; ai < 2; ++ai)
#pragma unroll
            for (int m = 0; m < 4; ++m) {
                const int row = row0 + ai * 128 + m * 16;
                float* zrow = Z + (size_t)row * NIN + seg * 512 + cs0;
                float* orow = nullptr;
                f32x4 vv[2][2];
                if (seg == 1 || seg == 2) {
                    if (row < MP) { const int b = row >> 12, t = row & 4095;
                        if (t >= 2048) orow = out + (seg == 1 ? OFF_KP : OFF_VP) + ((size_t)(l * 4 + b) * 2048 + (t - 2048)) * 512 + cs0; }
                    else orow = out + (seg == 1 ? OFF_KS : OFF_VS) + ((size_t)l * 256 + (row - MP)) * 512 + cs0;
                }
#pragma unroll
                for (int bj = 0; bj < 2; ++bj)
#pragma unroll
                    for (int n = 0; n < 2; ++n) {
                        f32x4 v = acc[ai][bj][m][n];
                        if (seg == 0) v = v * 0.125f;
                        else if (seg == 3 || seg == 6) { v[0] = silu_f(v[0]); v[1] = silu_f(v[1]); v[2] = silu_f(v[2]); v[3] = silu_f(v[3]); }
                        else if (seg == 4) {
                            const f32x4 b4 = lbv[bj][n];
#pragma unroll
                            for (int i = 0; i < 4; ++i) v[i] = b4[i] + (1.f - b4[i]) * sigmoid_f(v[i]);
                        }
                        if (!(seg < 3 && row < MP)) *(f32x4*)(zrow + bj * 128 + 4 * n) = v;
                        if (orow) *(f32x4*)(orow + bj * 128 + 4 * n) = v;
                        vv[bj][n] = v;
                    }
                if (seg < 3 && row < MP) {
                    bf16* qrow = QKV + (size_t)seg * MP * 512 + (size_t)row * 512 + cs0;
#pragma unroll
                    for (int bj = 0; bj < 2; ++bj) { v4u w; w.x = pk2(vv[bj][0][0], vv[bj][0][1]); w.y = pk2(vv[bj][0][2], vv[bj][0][3]); w.z = pk2(vv[bj][1][0], vv[bj][1][1]); w.w = pk2(vv[bj][1][2], vv[bj][1][3]);
                        *(v4u*)(qrow + bj * 128) = w; }
                }
            }
    }
};

__device__ __forceinline__ void p0_transpose_item(const float* W, int K, int N, bf16* WT, int mode, LAS float* scr, int item, int lane) {
    const int nblk = N / 32, kb = item / nblk, nb = item % nblk, k0 = 64 * kb, n0 = 32 * nb;
    const int r0 = (mode == 0) ? n0 : ((n0 >> 7) * 256 + (mode - 1) * 128 + (n0 & 127));
#pragma unroll 8
    for (int i = 0; i < 32; ++i) { const int kk = 2 * i + (lane >> 5); scr[kk * 33 + (lane & 31)] = W[(size_t)(k0 + kk) * N + n0 + (lane & 31)]; }
    LDS_WAIT(); asm volatile("" ::: "memory");
    const int c = lane & 7;
#pragma unroll
    for (int j = 0; j < 4; ++j) { const int n = (lane >> 3) + 8 * j; const LAS float* s = scr + (8 * c) * 33 + n;
        v4u o; o.x = pk2(s[0 * 33], s[1 * 33]); o.y = pk2(s[2 * 33], s[3 * 33]); o.z = pk2(s[4 * 33], s[5 * 33]); o.w = pk2(s[6 * 33], s[7 * 33]);
        *(v4u*)(WT + (size_t)(r0 + n) * K + k0 + 8 * c) = o; }
    LDS_WAIT(); asm volatile("" ::: "memory");
}

template <bool HAS_Y>
__device__ __forceinline__ void row_phase(const float* res_p, const float* res_s  , const float* Y, const float* post_g, float coef,
                                          float* hout, const float* pre_g, bf16* xn, int gw, int NGW, int lane) {
    for (int row = gw; row < M; row += NGW) {
        const float* rp = (res_s && row >= MP) ? res_s + (size_t)(row - MP) * D : res_p + (size_t)row * D;
        f32x4 v[4];
#pragma unroll
        for (int j = 0; j < 4; ++j) v[j] = *((const f32x4*)rp + lane + 64 * j);
        if (HAS_Y) {
            f32x4 y[4]; float s = 0.f;
#pragma unroll
            for (int j = 0; j < 4; ++j) { y[j] = *((const f32x4*)(Y + (size_t)row * D) + lane + 64 * j); s += (y[j][0] * y[j][0] + y[j][1] * y[j][1]) + (y[j][2] * y[j][2] + y[j][3] * y[j][3]); }
            const float rstd = coef * rsqrtf(wave_sum(s) * (1.f / D) + EPS);
#pragma unroll
            for (int j = 0; j < 4; ++j) { const f32x4 g = *((const f32x4*)post_g + lane + 64 * j); v[j] = v[j] + y[j] * g * rstd; }
        }
        if (hout) {
#pragma unroll
            for (int j = 0; j < 4; ++j) *((f32x4*)(hout + (size_t)row * D) + lane + 64 * j) = v[j];
        }
        if (pre_g) {
            float s = 0.f;
#pragma unroll
            for (int j = 0; j < 4; ++j) s += (v[j][0] * v[j][0] + v[j][1] * v[j][1]) + (v[j][2] * v[j][2] + v[j][3] * v[j][3]);
            const float rstd = rsqrtf(wave_sum(s) * (1.f / D) + EPS);
            unsigned long long* o8 = (unsigned long long*)(xn + (size_t)row * D) + lane;
#pragma unroll
            for (int j = 0; j < 4; ++j) { const f32x4 g = *((const f32x4*)pre_g + lane + 64 * j); const f32x4 w = v[j] * g * rstd;
                o8[64 * j] = (unsigned long long)pk2(w[0], w[1]) | ((unsigned long long)pk2(w[2], w[3]) << 32); }
        }
    }
}

__device__ __forceinline__ float bflo(unsigned u) { return __builtin_bit_cast(float, u << 16); }
__device__ __forceinline__ float bfhi(unsigned u) { return __builtin_bit_cast(float, u & 0xffff0000u); }
__device__ __forceinline__ void r3_phase(const bf16* OP, const float* LSE, const float* OH, const float* Z, const float* attn_g, const float* hgrn_g, bf16* O, int gw, int NGW, int lane) {
    for (int row = gw; row < M; row += NGW) {
        f32x4 a0, a1;
        {
            const int hd = lane >> 3;
            const float l0 = LSE[((size_t)0 * M + row) * 8 + hd], l1 = LSE[((size_t)1 * M + row) * 8 + hd], l2 = LSE[((size_t)2 * M + row) * 8 + hd];
            const float mx = fmaxf(l0, fmaxf(l1, l2));
            float w0 = __expf(l0 - mx), w1 = __expf(l1 - mx), w2 = __expf(l2 - mx);
            const float iw = 1.f / (w0 + w1 + w2); w0 *= iw; w1 *= iw; w2 *= iw;
            const v4u p0 = *((const v4u*)(OP + ((size_t)0 * M + row) * 512) + lane), p1 = *((const v4u*)(OP + ((size_t)1 * M + row) * 512) + lane), p2 = *((const v4u*)(OP + ((size_t)2 * M + row) * 512) + lane);
            a0[0] = w0 * bflo(p0.x) + w1 * bflo(p1.x) + w2 * bflo(p2.x); a0[1] = w0 * bfhi(p0.x) + w1 * bfhi(p1.x) + w2 * bfhi(p2.x);
            a0[2] = w0 * bflo(p0.y) + w1 * bflo(p1.y) + w2 * bflo(p2.y); a0[3] = w0 * bfhi(p0.y) + w1 * bfhi(p1.y) + w2 * bfhi(p2.y);
            a1[0] = w0 * bflo(p0.z) + w1 * bflo(p1.z) + w2 * bflo(p2.z); a1[1] = w0 * bfhi(p0.z) + w1 * bfhi(p1.z) + w2 * bfhi(p2.z);
            a1[2] = w0 * bflo(p0.w) + w1 * bflo(p1.w) + w2 * bflo(p2.w); a1[3] = w0 * bfhi(p0.w) + w1 * bfhi(p1.w) + w2 * bfhi(p2.w);
        }
        float sa = (a0[0] * a0[0] + a0[1] * a0[1]) + (a0[2] * a0[2] + a0[3] * a0[3]) + (a1[0] * a1[0] + a1[1] * a1[1]) + (a1[2] * a1[2] + a1[3] * a1[3]);
        sa = wave_sum(sa);
        const float ra = rsqrtf(sa * (1.f / 512.f) + EPS);
        const f32x4 ag0 = *((const f32x4*)attn_g + 2 * lane), ag1 = *((const f32x4*)attn_g + 2 * lane + 1);
        const f32x4 oa0 = a0 * ag0 * ra, oa1 = a1 * ag1 * ra;
        v4u wa;
        wa.x = pk2(oa0[0], oa0[1]); wa.y = pk2(oa0[2], oa0[3]); wa.z = pk2(oa1[0], oa1[1]); wa.w = pk2(oa1[2], oa1[3]);
        *((v4u*)(O + (size_t)row * D) + lane) = wa;
        if (row >= MP) {
            const f32x4 h0 = *((const f32x4*)(OH + (size_t)row * 512) + 2 * lane), h1 = *((const f32x4*)(OH + (size_t)row * 512) + 2 * lane + 1);
            const f32x4 g0 = *((const f32x4*)(Z + (size_t)row * NIN + SEG_BG) + 2 * lane), g1 = *((const f32x4*)(Z + (size_t)row * NIN + SEG_BG) + 2 * lane + 1);
            float sh = (h0[0] * h0[0] + h0[1] * h0[1]) + (h0[2] * h0[2] + h0[3] * h0[3]) + (h1[0] * h1[0] + h1[1] * h1[1]) + (h1[2] * h1[2] + h1[3] * h1[3]);
#pragma unroll
            for (int o = 1; o < 16; o <<= 1) sh += __shfl_xor(sh, o);
            const float rh = rsqrtf(sh * (1.f / 128.f) + EPS);
            const f32x4 hg0 = *((const f32x4*)hgrn_g + 2 * (lane & 15)), hg1 = *((const f32x4*)hgrn_g + 2 * (lane & 15) + 1);
            const f32x4 ob0 = h0 * hg0 * rh * g0, ob1 = h1 * hg1 * rh * g1;
            v4u wb;
            wb.x = pk2(ob0[0], ob0[1]); wb.y = pk2(ob0[2], ob0[3]); wb.z = pk2(ob1[0], ob1[1]); wb.w = pk2(ob1[2], ob1[3]);
            *((v4u*)(O + (size_t)row * D + 512) + lane) = wb;
        }
    }
}

typedef float f32x2 __attribute__((ext_vector_type(2)));
struct HgIn { f32x4 f, q; float v; };
__device__ __forceinline__ void hg_load(HgIn (&d)[4], const float* Z, int rowbase, int t0, int T, int h, int kq, int vcol) {
#pragma unroll
    for (int i = 0; i < 4; ++i) {
        int t = t0 + i; t = t < T ? t : T - 1;
        const float* zr = Z + (size_t)(rowbase + t) * NIN + h * 128;
        d[i].f = *(const f32x4*)(zr + SEG_BF + kq * 4); d[i].q = *(const f32x4*)(zr + SEG_BQ + kq * 4);
        d[i].v = zr[SEG_BI + vcol];
    }
}
__device__ __forceinline__ void hg_step4(const HgIn (&d)[4], f32x2& Sa, f32x2& Sb, LAS float* scr, int slot0, int lane) {
#pragma unroll
    for (int i = 0; i < 4; ++i) {
        const f32x2 vv = {d[i].v, d[i].v};
        const f32x2 fa = {d[i].f[0], d[i].f[1]}, fb = {d[i].f[2], d[i].f[3]}, qa = {d[i].q[0], d[i].q[1]}, qb = {d[i].q[2], d[i].q[3]};
        Sa = fa * (Sa - vv) + vv; Sb = fb * (Sb - vv) + vv;
        const f32x2 pr = qa * Sa + qb * Sb;
        scr[(slot0 + i) * 64 + lane] = pr[0] + pr[1];
    }
}
template <int BS>
__device__ __forceinline__ void hgrn_task(const float* Z, float* OH, const float* s0, float* sout, int rowbase, int T, int h, int vg, LAS float* scr, int lane) {
    const int kq = lane & 31, g = lane >> 5, vcol = vg * 2 + g;
    f32x2 Sa, Sb;
    Sa[0] = s0 ? s0[(size_t)(kq * 4 + 0) * 128 + vcol] : 0.f; Sa[1] = s0 ? s0[(size_t)(kq * 4 + 1) * 128 + vcol] : 0.f;
    Sb[0] = s0 ? s0[(size_t)(kq * 4 + 2) * 128 + vcol] : 0.f; Sb[1] = s0 ? s0[(size_t)(kq * 4 + 3) * 128 + vcol] : 0.f;
    HgIn A[4], B[4];
    hg_load(A, Z, rowbase, 0, T, h, kq, vcol);
    for (int t0 = 0; t0 < T; t0 += BS) {
#pragma unroll 1
        for (int u = 0; u < BS; u += 8) {
            hg_load(B, Z, rowbase, t0 + u + 4, T, h, kq, vcol);
            hg_step4(A, Sa, Sb, scr, u, lane);
            hg_load(A, Z, rowbase, t0 + u + 8, T, h, kq, vcol);
            hg_step4(B, Sa, Sb, scr, u + 4, lane);
        }
        __builtin_amdgcn_wave_barrier(); LDS_WAIT();
        if (kq < BS) {
            float sum = 0.f;
#pragma unroll 8
            for (int i = 0; i < 32; ++i) sum += scr[kq * 64 + g * 32 + ((i + kq) & 31)];
            OH[(size_t)(rowbase + t0 + kq) * 512 + h * 128 + vcol] = sum;
        }
        __builtin_amdgcn_wave_barrier(); LDS_WAIT();
    }
    sout[(size_t)(kq * 4 + 0) * 128 + vcol] = Sa[0]; sout[(size_t)(kq * 4 + 1) * 128 + vcol] = Sa[1];
    sout[(size_t)(kq * 4 + 2) * 128 + vcol] = Sb[0]; sout[(size_t)(kq * 4 + 3) * 128 + vcol] = Sb[1];
}

__device__ __forceinline__ void hgrn_sample_task(int task, int l, const float* Z, float* OH, const float* s_in, float* s_out, LAS float* scr, int lane) {
    const int b = task >> 6, h = (task >> 4) & 3, vq = task & 15;
    const int kq = lane & 31, g = lane >> 5, vc0 = (vq * 2 + g) * 4;
    const size_t so = ((size_t)(l * 32 + b) * 4 + h) * 16384;
    f32x4 S[4];
#pragma unroll
    for (int k = 0; k < 4; ++k) S[k] = *(const f32x4*)(s_in + so + (size_t)(kq * 4 + k) * 128 + vc0);
    f32x4 fv[8], qv[8], vv[8];
#pragma unroll
    for (int t = 0; t < 8; ++t) {
        const float* zr = Z + (size_t)(MP + b * 8 + t) * NIN + h * 128;
        fv[t] = *(const f32x4*)(zr + SEG_BF + kq * 4); qv[t] = *(const f32x4*)(zr + SEG_BQ + kq * 4); vv[t] = *(const f32x4*)(zr + SEG_BI + vc0);
    }
#pragma unroll
    for (int t = 0; t < 8; ++t) {
        f32x4 pr = {0.f, 0.f, 0.f, 0.f};
#pragma unroll
        for (int k = 0; k < 4; ++k) { S[k] = (S[k] - vv[t]) * fv[t][k] + vv[t]; pr = pr + S[k] * qv[t][k]; }
#pragma unroll
        for (int v = 0; v < 4; ++v) scr[(t * 4 + v) * 64 + lane] = pr[v];
    }
    __builtin_amdgcn_wave_barrier(); LDS_WAIT();
    {
        const int t = lane >> 3, g2 = (lane >> 2) & 1, v = lane & 3;
        float sum = 0.f;
#pragma unroll 8
        for (int i = 0; i < 32; ++i) sum += scr[(t * 4 + v) * 64 + g2 * 32 + ((i + lane) & 31)];
        OH[(size_t)(MP + b * 8 + t) * 512 + h * 128 + (vq * 2 + g2) * 4 + v] = sum;
    }
#pragma unroll
    for (int k = 0; k < 4; ++k) *(f32x4*)(s_out + so + (size_t)(kq * 4 + k) * 128 + vc0) = S[k];
    __builtin_amdgcn_wave_barrier(); LDS_WAIT();
}

typedef short bf16x8 __attribute__((ext_vector_type(8)));
typedef float f32x16 __attribute__((ext_vector_type(16)));
typedef float f32x2_t __attribute__((ext_vector_type(2))); typedef __bf16 bf16x2_t __attribute__((ext_vector_type(2)));
__device__ __forceinline__ unsigned cvtpk(float lo, float hi) { f32x2_t v = {lo, hi}; bf16x2_t b = __builtin_convertvector(v, bf16x2_t); return __builtin_bit_cast(unsigned, b); }
#define MFMA32(a, b, c) __builtin_amdgcn_mfma_f32_32x32x16_bf16((a), (b), (c), 0, 0, 0)
__device__ __forceinline__ void attn_unit(int u, const bf16* QB, const bf16* KB, const bf16* VB, bf16* OP, float* LSE, LAS unsigned char* vimg, int lane) {
    const int h = u & 7; int t = u >> 3; const int tile = t & 127; t >>= 7; const int p = t % 3, b = t / 3;
    const int sh = 2 * p, r = tile >> (7 - sh), qt = tile & ((128 >> sh) - 1);
    const int c = lane & 31, hi = lane >> 5;
    const int qrow = b * SEQ + ((32 * qt + c) << sh) + r;
    bf16x8 qf[4];
#pragma unroll
    for (int ks = 0; ks < 4; ++ks) qf[ks] = *(const bf16x8*)(QB + (size_t)qrow * 512 + h * 64 + ks * 16 + hi * 8);
    f32x16 o0, o1;
#pragma unroll
    for (int i = 0; i < 16; ++i) { o0[i] = 0.f; o1[i] = 0.f; }
    float m = -INFINITY, l = 0.f;
    const int pr = (c & 0x13) | ((c & 8) >> 1) | ((c & 4) << 1);
    const int kt0 = (qt >= 4) ? 0 : 4 - qt;
    const int kb0 = 32 * qt - 128;
    const bf16* kbase = KB + h * 64 + hi * 8; const bf16* vbase = VB + h * 64 + hi * 8;
    bf16x8 kf[2][4], vf[2][4];
#define ATT_LOAD(KT, BUF) do { const int kb_ = kb0 + 32 * (KT); const size_t kr_ = (size_t)(b * SEQ + ((kb_ + pr) << sh) + r) * 512, vr_ = (size_t)(b * SEQ + ((kb_ + c) << sh) + r) * 512; \
        _Pragma("unroll") for (int ks = 0; ks < 4; ++ks) kf[BUF][ks] = *(const bf16x8*)(kbase + kr_ + ks * 16); \
        _Pragma("unroll") for (int ks = 0; ks < 4; ++ks) vf[BUF][ks] = *(const bf16x8*)(vbase + vr_ + ks * 16); } while (0)
#pragma unroll
    for (int kt = 0; kt < 5; ++kt) {
        if (kt == kt0) ATT_LOAD(kt, kt & 1);
        if (kt >= kt0) {
            if (kt < 4) ATT_LOAD(kt + 1, (kt + 1) & 1);
            f32x16 s;
#pragma unroll
            for (int i = 0; i < 16; ++i) s[i] = 0.f;
#pragma unroll
            for (int ks = 0; ks < 4; ++ks) s = MFMA32(kf[kt & 1][ks], qf[ks], s);
#pragma unroll
            for (int ks = 0; ks < 4; ++ks)
#pragma unroll
                for (int e = 0; e < 8; ++e) *(LAS short*)(vimg + (ks * 16 + hi * 8 + e) * 80 + c * 2) = vf[kt & 1][ks][e];
            if (kt == 0) {
#pragma unroll
                for (int i = 0; i < 16; ++i) { const int ko = 16 * (i >> 3) + 8 * hi + (i & 7); s[i] = (ko >= c) ? s[i] : -INFINITY; }
            } else if (kt == 4) {
#pragma unroll
                for (int i = 0; i < 16; ++i) { const int ko = 16 * (i >> 3) + 8 * hi + (i & 7); s[i] = (ko <= c) ? s[i] : -INFINITY; }
            }
            float tmax = s[0];
#pragma unroll
            for (int i = 1; i < 16; ++i) tmax = fmaxf(tmax, s[i]);
            tmax = fmaxf(tmax, __shfl_xor(tmax, 32));
            const float mn = fmaxf(m, tmax), alpha = __expf(m - mn);
            float ls = 0.f;
#pragma unroll
            for (int i = 0; i < 16; ++i) { s[i] = __expf(s[i] - mn); ls += s[i]; }
            ls += __shfl_xor(ls, 32);
            l = l * alpha + ls; m = mn;
#pragma unroll
            for (int i = 0; i < 16; ++i) { o0[i] *= alpha; o1[i] *= alpha; }
            bf16x8 pf[2];
#pragma unroll
            for (int s2 = 0; s2 < 2; ++s2) { v4u w; w.x = cvtpk(s[8 * s2 + 0], s[8 * s2 + 1]); w.y = cvtpk(s[8 * s2 + 2], s[8 * s2 + 3]); w.z = cvtpk(s[8 * s2 + 4], s[8 * s2 + 5]); w.w = cvtpk(s[8 * s2 + 6], s[8 * s2 + 7]);
                pf[s2] = __builtin_bit_cast(bf16x8, w); }
            __builtin_amdgcn_wave_barrier(); LDS_WAIT();
#pragma unroll
            for (int s2 = 0; s2 < 2; ++s2) {
                const bf16x8 a0 = *(const LAS bf16x8*)(vimg + c * 80 + (16 * s2 + 8 * hi) * 2);
                const bf16x8 a1 = *(const LAS bf16x8*)(vimg + (32 + c) * 80 + (16 * s2 + 8 * hi) * 2);
                o0 = MFMA32(a0, pf[s2], o0); o1 = MFMA32(a1, pf[s2], o1);
            }
            __builtin_amdgcn_wave_barrier(); LDS_WAIT();
        }
    }
#undef ATT_LOAD
    const float inv = 1.f / l;
    bf16* orow = OP + ((size_t)p * M + qrow) * 512 + h * 64;
#pragma unroll
    for (int gq = 0; gq < 4; ++gq) {
        unsigned long long w0 = (unsigned long long)cvtpk(o0[4 * gq] * inv, o0[4 * gq + 1] * inv) | ((unsigned long long)cvtpk(o0[4 * gq + 2] * inv, o0[4 * gq + 3] * inv) << 32);
        unsigned long long w1 = (unsigned long long)cvtpk(o1[4 * gq] * inv, o1[4 * gq + 1] * inv) | ((unsigned long long)cvtpk(o1[4 * gq + 2] * inv, o1[4 * gq + 3] * inv) << 32);
        *(unsigned long long*)(orow + 8 * gq + 4 * hi) = w0;
        *(unsigned long long*)(orow + 32 + 8 * gq + 4 * hi) = w1;
    }
    if (hi == 0) LSE[((size_t)p * M + qrow) * 8 + h] = m + __logf(l);
}

__device__ __forceinline__ const float* skv_ptr(int b, int idx, int h, int seg, const float* Z, const float* cache, int l) {
    if (idx >= 2048) return Z + (size_t)(MP + b * 8 + (idx - 2048)) * NIN + seg + h * 64;
    return cache + ((((size_t)l * 32 + b) * 2048 + idx) * 8 + h) * 64;
}
__device__ __forceinline__ v4u aent(float c, const float* p) { v4u e; e.x = __builtin_bit_cast(unsigned, c); e.y = 0u; const unsigned long long a = (unsigned long long)p; e.z = (unsigned)a; e.w = (unsigned)(a >> 32); return e; }
__device__ __forceinline__ float dot64(const f32x4 (&q)[16], const float* kp) {
    float a0 = 0.f, a1 = 0.f, a2 = 0.f, a3 = 0.f;
#pragma unroll
    for (int i = 0; i < 16; ++i) { const f32x4 k = *((const f32x4*)kp + i); a0 = fmaf(q[i][0], k[0], a0); a1 = fmaf(q[i][1], k[1], a1); a2 = fmaf(q[i][2], k[2], a2); a3 = fmaf(q[i][3], k[3], a3); }
    return (a0 + a1) + (a2 + a3);
}
__device__ __forceinline__ void attn_sample_item(int it, int l, const float* Z, const float* ck, const float* cv, bf16* OP, float* LSE, LAS v4u* scr, int lane) {
    const int p = it % 3, h = (it / 3) & 7, rs = it / 24, b = rs >> 3, pos = 2048 + (rs & 7), row = MP + rs, d = 1 << (2 * p);
    float s0, sa, sb;
    const int ia = pos - d * (1 + lane), ib = pos - d * (65 + lane);
    {
        const float* qp = Z + (size_t)row * NIN + SEG_Q + h * 64;
        f32x4 q[16];
#pragma unroll
        for (int i = 0; i < 16; ++i) q[i] = *((const f32x4*)qp + i);
        s0 = dot64(q, skv_ptr(b, pos, h, SEG_K, Z, ck, l));
        sa = dot64(q, skv_ptr(b, ia, h, SEG_K, Z, ck, l));
        sb = dot64(q, skv_ptr(b, ib, h, SEG_K, Z, ck, l));
    }
    const float m = fmaxf(s0, wave_max(fmaxf(sa, sb)));
    const float e0 = __expf(s0 - m), ea = __expf(sa - m), eb = __expf(sb - m);
    const float lsum = e0 + wave_sum(ea + eb), inv = 1.f / lsum;
    const float* vself = skv_ptr(b, pos, h, SEG_V, Z, cv, l);
    scr[1 + lane] = aent(ea * inv, skv_ptr(b, ia, h, SEG_V, Z, cv, l));
    scr[65 + lane] = aent(eb * inv, skv_ptr(b, ib, h, SEG_V, Z, cv, l));
    if (lane < 4) scr[lane == 0 ? 0 : 128 + lane] = aent(lane == 0 ? e0 * inv : 0.f, vself);
    __builtin_amdgcn_wave_barrier(); LDS_WAIT();
    const int ks = lane >> 4, c4 = (lane & 15) * 4;
    f32x4 acc = {0.f, 0.f, 0.f, 0.f};
#pragma unroll
    for (int hb = 0; hb < 2; ++hb) {
        f32x4 vb[17]; float cf[17];
#pragma unroll
        for (int j = 0; j < 17; ++j) { const int i = hb * 17 + j; if (i < 33) { const v4u e = scr[4 * i + ks]; const float* vp = (const float*)(((unsigned long long)e.w << 32) | e.z);
            vb[j] = *(const f32x4*)(vp + c4); cf[j] = __builtin_bit_cast(float, e.x); } }
        asm volatile("" ::: "memory");
#pragma unroll
        for (int j = 0; j < 17; ++j) { if (hb * 17 + j < 33) acc = acc + vb[j] * cf[j]; }
    }
#pragma unroll
    for (int i = 0; i < 4; ++i) { acc[i] += __shfl_xor(acc[i], 16); acc[i] += __shfl_xor(acc[i], 32); }
    if (lane < 16) *(unsigned long long*)(OP + ((size_t)p * M + row) * 512 + h * 64 + c4) = (unsigned long long)cvtpk(acc[0], acc[1]) | ((unsigned long long)cvtpk(acc[2], acc[3]) << 32);
    if (lane == 0) LSE[((size_t)p * M + row) * 8 + h] = m + __logf(lsum);
    __builtin_amdgcn_wave_barrier(); LDS_WAIT();
}

__device__ __forceinline__ void hg_pass_a(int unit, const float* Z, float* U, float* DEC, LAS unsigned char* img, int lane) {
    const int kh = unit & 1, vh = (unit >> 1) & 1, cg = unit >> 2, c = cg & 63, seq = cg >> 6, h = seq & 3, b = seq >> 2;
    const size_t rowbase = (size_t)b * SEQ + c * 64;
    const float* zf = Z + rowbase * NIN + SEG_BF + h * 128 + kh * 64 + lane;
    const float* zv = Z + rowbase * NIN + SEG_BI + h * 128 + vh * 64 + lane;
    LAS unsigned char* imk = img; LAS unsigned char* imv = img + 9216;
    {
        float fv[64], lg[64]; float tot = 0.f;
#pragma unroll
        for (int t = 0; t < 64; ++t) { fv[t] = zf[(size_t)t * NIN]; }
#pragma unroll
        for (int t = 0; t < 64; ++t) { lg[t] = __logf(fv[t]); tot += lg[t]; }
        float g = 0.f;
#pragma unroll
        for (int t8 = 0; t8 < 8; ++t8) {
            float kk[8];
#pragma unroll
            for (int j = 0; j < 8; ++j) { const float f = fv[t8 * 8 + j]; g += lg[t8 * 8 + j]; kk[j] = (1.f - f) * __expf(tot - g); }
            v4u w; w.x = cvtpk(kk[0], kk[1]); w.y = cvtpk(kk[2], kk[3]); w.z = cvtpk(kk[4], kk[5]); w.w = cvtpk(kk[6], kk[7]);
            *(LAS v4u*)(imk + lane * 144 + t8 * 16) = w;
        }
        if (vh == 0) DEC[(size_t)cg * 128 + kh * 64 + lane] = __expf(tot);
    }
    {
#pragma unroll
        for (int t8 = 0; t8 < 8; ++t8) {
            float vv[8];
#pragma unroll
            for (int j = 0; j < 8; ++j) vv[j] = zv[(size_t)(t8 * 8 + j) * NIN];
            v4u w; w.x = cvtpk(vv[0], vv[1]); w.y = cvtpk(vv[2], vv[3]); w.z = cvtpk(vv[4], vv[5]); w.w = cvtpk(vv[6], vv[7]);
            *(LAS v4u*)(imv + lane * 144 + t8 * 16) = w;
        }
    }
    __builtin_amdgcn_wave_barrier(); LDS_WAIT();
    const int cc = lane & 31, hi = lane >> 5;
#pragma unroll
    for (int vt = 0; vt < 2; ++vt)
#pragma unroll
        for (int kt = 0; kt < 2; ++kt) {
            f32x16 acc;
#pragma unroll
            for (int i = 0; i < 16; ++i) acc[i] = 0.f;
#pragma unroll
            for (int ts = 0; ts < 4; ++ts) {
                const bf16x8 a = *(const LAS bf16x8*)(imv + (vt * 32 + cc) * 144 + (16 * ts + 8 * hi) * 2);
                const bf16x8 bb = *(const LAS bf16x8*)(imk + (kt * 32 + cc) * 144 + (16 * ts + 8 * hi) * 2);
                acc = MFMA32(a, bb, acc);
            }
            float* up = U + ((size_t)cg * 128 + vh * 64 + vt * 32) * 128 + kh * 64 + kt * 32 + cc;
#pragma unroll
            for (int i = 0; i < 16; ++i) up[(size_t)((i & 3) + 8 * (i >> 2) + 4 * hi) * 128] = acc[i];
        }
    __builtin_amdgcn_wave_barrier(); LDS_WAIT();
}
__device__ __forceinline__ void hg_pass_b(const float* __restrict__ U, const float* __restrict__ DEC, bf16* __restrict__ SPREV, float* __restrict__ sfin, int gtid, int nthr) {
    for (int e = gtid * 2; e < 16 * 16384; e += nthr * 2) {
        const int seq = e >> 14, v = (e >> 7) & 127, k = e & 127;
        f32x2 S = {0.f, 0.f};
        const size_t eo = (size_t)v * 128 + k;
#pragma unroll 8
        for (int c = 0; c < 64; ++c) {
            const size_t cg = (size_t)seq * 64 + c;
            const f32x2 u = *(const f32x2*)(U + cg * 16384 + eo), dd = *(const f32x2*)(DEC + cg * 128 + k);
            *(unsigned*)(SPREV + cg * 16384 + eo) = cvtpk(S[0], S[1]);
            S = dd * S + u;
        }
        sfin[(size_t)seq * 16384 + (size_t)k * 128 + v] = S[0];
        sfin[(size_t)seq * 16384 + (size_t)(k + 1) * 128 + v] = S[1];
    }
}
constexpr int PC_QT = 0, PC_Q1 = 17408, PC_K0 = 26112, PC_K1 = 34816, PC_VT = 52224, PC_AM = 70656, PC_PRE = 79872, PC_RED = 81920;
__device__ __forceinline__ float exp_c(float x) { return __expf(fminf(x, 80.f)); }
__device__ __forceinline__ void hg_pass_c(int cg, const float* Z, const bf16* SPREV, const float* hgrn_g, bf16* O, LAS unsigned char* lds, int tid) {
    const int c = cg & 63, seq = cg >> 6, h = seq & 3, b = seq >> 2;
    const size_t rowbase = (size_t)b * SEQ + c * 64;
    const int kd = tid & 127, tq = tid >> 7, lane = tid & 63, wave = tid >> 6, cc = lane & 31, hi = lane >> 5;
    LAS float* PRE = (LAS float*)(lds + PC_PRE); LAS float* RED = (LAS float*)(lds + PC_RED);
    {
        const float* zr = Z + (rowbase + tq * 16) * NIN + h * 128 + kd;
        float fv[16], cs[16]; float run = 0.f;
#pragma unroll
        for (int j = 0; j < 16; ++j) fv[j] = zr[(size_t)j * NIN + SEG_BF];
#pragma unroll
        for (int j = 0; j < 16; ++j) { run += __logf(fv[j]); cs[j] = run; }
        PRE[tq * 128 + kd] = run;
        {
            float vv[16];
#pragma unroll
            for (int j = 0; j < 16; ++j) vv[j] = zr[(size_t)j * NIN + SEG_BI];
            v4u w0, w1; w0.x = cvtpk(vv[0], vv[1]); w0.y = cvtpk(vv[2], vv[3]); w0.z = cvtpk(vv[4], vv[5]); w0.w = cvtpk(vv[6], vv[7]);
            w1.x = cvtpk(vv[8], vv[9]); w1.y = cvtpk(vv[10], vv[11]); w1.z = cvtpk(vv[12], vv[13]); w1.w = cvtpk(vv[14], vv[15]);
            *(LAS v4u*)(lds + PC_VT + kd * 144 + tq * 32) = w0; *(LAS v4u*)(lds + PC_VT + kd * 144 + tq * 32 + 16) = w1;
        }
        __syncthreads();
        const float p0 = PRE[kd], p1 = PRE[128 + kd], p2 = PRE[256 + kd];
        const float pre = (tq > 0 ? p0 : 0.f) + (tq > 1 ? p1 : 0.f) + (tq > 2 ? p2 : 0.f);
        const float g31 = p0 + p1;
#pragma unroll
        for (int j = 0; j < 16; ++j) {
            const int t = tq * 16 + j;
            const float g = pre + cs[j], q = zr[(size_t)j * NIN + SEG_BQ], kk = 1.f - fv[j];
            *(LAS unsigned short*)(lds + PC_QT + t * 272 + kd * 2) = (unsigned short)cvtpk(q * __expf(g), 0.f);
            *(LAS unsigned short*)(lds + PC_K1 + t * 272 + kd * 2) = (unsigned short)cvtpk(kk * exp_c(g31 - g), 0.f);
            if (tq >= 2) *(LAS unsigned short*)(lds + PC_Q1 + (t - 32) * 272 + kd * 2) = (unsigned short)cvtpk(q * __expf(g - g31), 0.f);
            else         *(LAS unsigned short*)(lds + PC_K0 + t * 272 + kd * 2) = (unsigned short)cvtpk(kk * exp_c(-g), 0.f);
        }
    }
    __syncthreads();
    if (wave < 3) {
        const int st = (wave == 2) ? 1 : 0, tt = (wave == 0) ? 0 : 1;
        LAS unsigned char* kim = lds + (wave == 0 ? PC_K0 : PC_K1) + (wave == 2 ? 32 * 272 : 0);
        LAS unsigned char* qim = lds + (wave == 0 ? PC_QT : PC_Q1);
        f32x16 acc;
#pragma unroll
        for (int i = 0; i < 16; ++i) acc[i] = 0.f;
#pragma unroll
        for (int ks = 0; ks < 8; ++ks) {
            const bf16x8 a = *(const LAS bf16x8*)(kim + cc * 272 + (16 * ks + 8 * hi) * 2);
            const bf16x8 bq = *(const LAS bf16x8*)(qim + cc * 272 + (16 * ks + 8 * hi) * 2);
            acc = MFMA32(a, bq, acc);
        }
        if (wave != 1) {
#pragma unroll
            for (int i = 0; i < 16; ++i) { const int sl = (i & 3) + 8 * (i >> 2) + 4 * hi; acc[i] = (sl <= cc) ? acc[i] : 0.f; }
        }
#pragma unroll
        for (int gq = 0; gq < 4; ++gq)
            *(LAS unsigned long long*)(lds + PC_AM + (tt * 32 + cc) * 144 + (st * 32 + 8 * gq + 4 * hi) * 2) =
                (unsigned long long)cvtpk(acc[4 * gq], acc[4 * gq + 1]) | ((unsigned long long)cvtpk(acc[4 * gq + 2], acc[4 * gq + 3]) << 32);
    }
    __syncthreads();
    {
        const int vt = wave >> 1, tt = wave & 1;
        f32x16 acc;
#pragma unroll
        for (int i = 0; i < 16; ++i) acc[i] = 0.f;
        const bf16* sp = SPREV + (size_t)cg * 16384 + (size_t)(vt * 32 + cc) * 128 + 8 * hi;
#pragma unroll
        for (int ks = 0; ks < 8; ++ks) {
            const bf16x8 a = *(const bf16x8*)(sp + 16 * ks);
            const bf16x8 bq = *(const LAS bf16x8*)(lds + PC_QT + (tt * 32 + cc) * 272 + (16 * ks + 8 * hi) * 2);
            acc = MFMA32(a, bq, acc);
        }
#pragma unroll
        for (int ss = 0; ss < 4; ++ss) {
            if (ss < 2 || tt == 1) {
                const bf16x8 a = *(const LAS bf16x8*)(lds + PC_VT + (vt * 32 + cc) * 144 + (16 * ss + 8 * hi) * 2);
                const bf16x8 ba = *(const LAS bf16x8*)(lds + PC_AM + (tt * 32 + cc) * 144 + (16 * ss + 8 * hi) * 2);
                acc = MFMA32(a, ba, acc);
            }
        }
        float ssq = 0.f;
#pragma unroll
        for (int i = 0; i < 16; ++i) ssq += acc[i] * acc[i];
        ssq += __shfl_xor(ssq, 32);
        if (hi == 0) RED[vt * 64 + tt * 32 + cc] = ssq;
        __syncthreads();
        const int t = tt * 32 + cc;
        const float rstd = rsqrtf((RED[t] + RED[64 + t] + RED[128 + t] + RED[192 + t]) * (1.f / 128.f) + EPS);
        const size_t row = rowbase + t;
#pragma unroll
        for (int gq = 0; gq < 4; ++gq) {
            const int v0 = vt * 32 + 8 * gq + 4 * hi;
            const f32x4 gate = *(const f32x4*)(Z + row * NIN + SEG_BG + h * 128 + v0), gg = *(const f32x4*)(hgrn_g + v0);
            const float x0 = acc[4 * gq] * rstd * gg[0] * gate[0], x1 = acc[4 * gq + 1] * rstd * gg[1] * gate[1], x2 = acc[4 * gq + 2] * rstd * gg[2] * gate[2], x3 = acc[4 * gq + 3] * rstd * gg[3] * gate[3];
            *(unsigned long long*)(O + row * D + 512 + h * 128 + v0) = (unsigned long long)cvtpk(x0, x1) | ((unsigned long long)cvtpk(x2, x3) << 32);
        }
    }
    __syncthreads();
}

template <int K>
__device__ __forceinline__ void small_gemm(const bf16* A, const bf16* Bt, float* Y, LAS unsigned char* lds, int bx, int G, int tid) {
    const int lane = tid & 63, wave = tid >> 6, cc = lane & 31, hi = lane >> 5;
    constexpr int NS = K / 16 / 8;
    for (int w = bx; w < 256; w += G) {
        const int rt = w >> 5, ct = w & 31;
        const bf16* ap = A + (size_t)(MP + rt * 32 + cc) * K + wave * NS * 16 + 8 * hi;
        const bf16* bp = Bt + (size_t)(ct * 32 + cc) * K + wave * NS * 16 + 8 * hi;
        f32x16 acc;
#pragma unroll
        for (int i = 0; i < 16; ++i) acc[i] = 0.f;
        constexpr int HB = (NS + 1) / 2;
#pragma unroll
        for (int hb = 0; hb < 2; ++hb) {
            bf16x8 af[HB], bfr[HB];
#pragma unroll
            for (int j = 0; j < HB; ++j) { const int ks = hb * HB + j; if (ks < NS) { af[j] = *(const bf16x8*)(ap + 16 * ks); bfr[j] = *(const bf16x8*)(bp + 16 * ks); } }
            asm volatile("" ::: "memory");
#pragma unroll
            for (int j = 0; j < HB; ++j) { const int ks = hb * HB + j; if (ks < NS) acc = MFMA32(af[j], bfr[j], acc); }
        }
        LAS float* red = (LAS float*)lds;
#pragma unroll
        for (int i = 0; i < 16; ++i) red[wave * 1024 + i * 64 + lane] = acc[i];
        __syncthreads();
#pragma unroll
        for (int e2 = 0; e2 < 2; ++e2) {
            const int ei = tid + 512 * e2; float sum = 0.f;
#pragma unroll
            for (int ww = 0; ww < 8; ++ww) sum += red[ww * 1024 + ei];
            const int i = ei >> 6, ln = ei & 63, row = (i & 3) + 8 * (i >> 2) + 4 * (ln >> 5), col = ln & 31;
            Y[(size_t)(MP + rt * 32 + row) * D + ct * 32 + col] = sum;
        }
        __syncthreads();
    }
}

#define XB_TMO      128
#define XB_XCNT(j)  (256  + 64 * (j))
#define XB_XSUB(j)  (1280 + 64 * (j))
#define XB_XGEN(j)  (2304 + 64 * (j))
#define XB_TOP      3328
#define XB_TOPGEN   3392
#define XCD_BAR_WORDS 3456
#define XB_SPIN_CAP (1u << 18)

__device__ __forceinline__ unsigned xb_ld(unsigned* p)              { return __hip_atomic_load(p, __ATOMIC_RELAXED, __HIP_MEMORY_SCOPE_AGENT); }
__device__ __forceinline__ unsigned xb_add(unsigned* p, unsigned v) { return __hip_atomic_fetch_add(p, v, __ATOMIC_RELAXED, __HIP_MEMORY_SCOPE_AGENT); }
__device__ __forceinline__ unsigned xb_xcc_id() { return (unsigned)__builtin_amdgcn_s_getreg((3 << 11) | 20) & 0xFu; }
#define XB_SPIN(cond, bar) do { unsigned _sp = 0; while (cond) { __builtin_amdgcn_s_sleep(1); \
    if ((++_sp & 255u) == 0u) { if (xb_ld(&(bar)[XB_TMO])) break; if (_sp > XB_SPIN_CAP) { atomicAdd(&(bar)[XB_TMO], 1u); break; } } } } while (0)

struct XcdBarrier {
    unsigned* bar; unsigned x;
    volatile LAS unsigned* st;
};

__device__ __forceinline__ XcdBarrier xcd_barrier_post(unsigned* bar, volatile LAS unsigned* st) {
    XcdBarrier b; b.bar = bar; b.x = xb_xcc_id(); b.st = st;
    if (threadIdx.x == 0) (void)xb_add(&bar[XB_XCNT(b.x)], 1u);
    return b;
}
__device__ __forceinline__ void xcd_barrier_complete(unsigned* bar, unsigned x, unsigned& nloc, unsigned& nx) {
    const unsigned G = gridDim.x * gridDim.y * gridDim.z;
    unsigned sum, cnt, mine, sp = 0u;
    for (;;) {
        sum = 0u; cnt = 0u; mine = 0u;
#pragma unroll
        for (unsigned j = 0; j < 16; ++j) { const unsigned c = xb_ld(&bar[XB_XCNT(j)]); sum += c; cnt += (c > 0u) ? 1u : 0u; mine = (j == x) ? c : mine; }
        if (sum == G) break;
        __builtin_amdgcn_s_sleep(1);
        if ((++sp & 255u) == 0u) { if (xb_ld(&bar[XB_TMO])) break; if (sp > XB_SPIN_CAP) { atomicAdd(&bar[XB_TMO], 1u); break; } }
    }
    nloc = mine > 0u ? mine : 1u; nx = cnt > 0u ? cnt : 1u;
}

__device__ __forceinline__ void xcd_barrier(const XcdBarrier& b) {
    asm volatile("s_waitcnt vmcnt(0)" ::: "memory");
    __syncthreads();
    if (threadIdx.x == 0) {
        unsigned* bar = b.bar;
        __builtin_amdgcn_s_waitcnt(0);
        unsigned nloc = b.st[0], nx = b.st[1];
        if (nloc == 0u) { xcd_barrier_complete(bar, b.x, nloc, nx); b.st[0] = nloc; b.st[1] = nx; }
        const unsigned old = xb_add(&bar[XB_XSUB(b.x)], 1u);
        const unsigned gen = old / nloc;
        if (old + 1u == (gen + 1u) * nloc) {
            __builtin_amdgcn_fence(__ATOMIC_RELEASE, "agent");
            asm volatile("s_waitcnt vmcnt(0)" ::: "memory");
            const unsigned og = xb_add(&bar[XB_TOP], 1u);
            const unsigned tg = og / nx;
            if (og + 1u == (tg + 1u) * nx) xb_add(&bar[XB_TOPGEN], 1u);
            else XB_SPIN(xb_ld(&bar[XB_TOPGEN]) == tg, bar);
            __builtin_amdgcn_fence(__ATOMIC_ACQUIRE, "agent");
            xb_add(&bar[XB_XGEN(b.x)], 1u);
            asm volatile("s_waitcnt vmcnt(0)" ::: "memory");
        } else {
            XB_SPIN(xb_ld(&bar[XB_XGEN(b.x)]) == gen, bar);
            __builtin_amdgcn_fence(__ATOMIC_ACQUIRE, "agent");
            asm volatile("s_waitcnt vmcnt(0)" ::: "memory");
        }
    }
    __syncthreads();
}

struct Args { const float* in[22]; float* out; unsigned char* ws; int ph_lo, ph_hi; };
constexpr int N_PHASES = 25;

__global__ void __launch_bounds__(NWAVES * 64, 2) mk_fwd(Args args) {
    extern __shared__ __attribute__((aligned(16))) unsigned char lds_raw[];
    LAS unsigned char* lds = (LAS unsigned char*)lds_raw;
    const int G = gridDim.x, bx = blockIdx.x, NGW = G * NWAVES;
#define FRESH() int tid_ = threadIdx.x; asm volatile("" : "+v"(tid_)); const int tid = tid_, lane = tid & 63, wave = __builtin_amdgcn_readfirstlane(tid >> 6), gw = bx * NWAVES + wave; (void)tid; (void)lane; (void)gw;
    unsigned char* ws = args.ws;
    float* LB = (float*)(ws + WS_LB);
    bf16* Wb = (bf16*)(ws + WS_W);
    bf16* XN = (bf16*)(ws + WS_XN); bf16* OB = (bf16*)(ws + WS_O); bf16* HID = (bf16*)(ws + WS_HID);
    float* Y = (float*)(ws + WS_Y); float* HR = (float*)(ws + WS_H); float* Z = (float*)(ws + WS_Z);
    float* OH = (float*)(ws + WS_OH);
    bf16* QB = (bf16*)(ws + WS_QB); bf16* OPB = (bf16*)(ws + WS_OP); float* LSE = (float*)(ws + WS_LSE);
    float* UU = (float*)(ws + WS_U); float* DEC = (float*)(ws + WS_DEC); bf16* SPREV = (bf16*)(ws + WS_SPREV);
    float* out = args.out;
    const int lo = args.ph_lo, hi = args.ph_hi;
#define IN(k) (lo <= (k) && (k) < hi)
#define SEAM(k) do { if (IN(k) && IN((k) + 1)) { if ((k) == 0) cg::this_grid().sync(); else xcd_barrier(xbar); } } while (0)
    volatile LAS unsigned* MISC = (volatile LAS unsigned*)(lds + LDS_MISC);
    if (threadIdx.x < 2) MISC[threadIdx.x] = 0u;
    __syncthreads();
    XcdBarrier xbar = xcd_barrier_post((unsigned*)(ws + WS_BAR), MISC);

    if (IN(0)) {
        FRESH();
        LAS float* scr = (LAS float*)(lds + wave * 16384);
        constexpr int I_FF = (D / 64) * (FF / 32), I_DN = (FF / 64) * (D / 32), I_IN = (D / 64) * (NIN / 32), I_OUT = (D / 64) * (D / 32);
        constexpr int I_LAYER = 4 * I_FF + 2 * I_DN + I_IN + I_OUT;
        for (int it = gw; it < 2 * I_LAYER; it += NGW) {
            const int l = it / I_LAYER; int r = it % I_LAYER;
            bf16* wl = Wb + (size_t)l * W_LAYER;
            if (r < I_FF) { p0_transpose_item(args.in[6] + (size_t)l * D * FF, D, FF, wl + W_G1, 1, scr, r, lane); continue; } r -= I_FF;
            if (r < I_FF) { p0_transpose_item(args.in[7] + (size_t)l * D * FF, D, FF, wl + W_G1, 2, scr, r, lane); continue; } r -= I_FF;
            if (r < I_DN) { p0_transpose_item(args.in[8] + (size_t)l * D * FF, FF, D, wl + W_D1, 0, scr, r, lane); continue; } r -= I_DN;
            if (r < I_IN) { p0_transpose_item(args.in[11] + (size_t)l * D * NIN, D, NIN, wl + W_IN, 0, scr, r, lane); continue; } r -= I_IN;
            if (r < I_OUT) { p0_transpose_item(args.in[15] + (size_t)l * D * D, D, D, wl + W_OUT, 0, scr, r, lane); continue; } r -= I_OUT;
            if (r < I_FF) { p0_transpose_item(args.in[18] + (size_t)l * D * FF, D, FF, wl + W_G2, 1, scr, r, lane); continue; } r -= I_FF;
            if (r < I_FF) { p0_transpose_item(args.in[19] + (size_t)l * D * FF, D, FF, wl + W_G2, 2, scr, r, lane); continue; } r -= I_FF;
            p0_transpose_item(args.in[20] + (size_t)l * D * FF, FF, D, wl + W_D2, 0, scr, r, lane);
        }
        if (bx == 0) {
            const float* lg = args.in[13];
            const float x0 = lg[tid], x1 = lg[512 + tid];
            LB[tid] = 0.f; LB[512 + tid] = 1.f / (1.f + __expf(x0 - x1));
        }
        row_phase<false>(args.in[0], args.in[1], nullptr, nullptr, 0.f, nullptr, args.in[5], XN, gw, NGW, lane);
    }
    SEAM(0);

#pragma unroll 1
    for (int l = 0; l < 2; ++l) {
        const int pb = 1 + 12 * l;
        const bf16* wl = Wb + (size_t)l * W_LAYER;
        if (IN(pb + 0)) {
            pg8::Gemm g{XN, wl + W_G1, M, 2 * FF, D}; pg8::StaticOrder S; S.init(M, 2 * FF, G, bx);
            EpiSwiglu E{HID};
            pg8::gemm_phase<EpiSwiglu, pg8::StaticOrder, true, true>(lds, g, S, E);
        }
        SEAM(pb + 0);
        if (IN(pb + 1)) {
            { FRESH(); small_gemm<FF>(HID, wl + W_D1, Y, lds, bx, G, tid); }
            pg8::Gemm g{HID, wl + W_D1, MP, D, FF}; pg8::StaticOrder S; S.init(MP, D, G, bx);
            EpiF32 E{Y, D};
            pg8::gemm_phase<EpiF32, pg8::StaticOrder, true, true>(lds, g, S, E);
        }
        SEAM(pb + 1);
        if (IN(pb + 2)) {
            FRESH();
            if (l == 0) row_phase<true>(args.in[0], args.in[1], Y, args.in[9] + l * D, 0.5f, HR, args.in[10] + l * D, XN, gw, NGW, lane);
            else        row_phase<true>(HR, nullptr, Y, args.in[9] + l * D, 0.5f, HR, args.in[10] + l * D, XN, gw, NGW, lane);
        }
        SEAM(pb + 2);
        if (IN(pb + 3)) {
            pg8::Gemm g{XN, wl + W_IN, M, NIN, D}; pg8::StaticOrder S; S.init(M, NIN, G, bx);
            EpiMix E{Z, LB + l * 512, out, l, QB};
            pg8::gemm_phase<EpiMix, pg8::StaticOrder, true, true>(lds, g, S, E);
        }
        SEAM(pb + 3);
        if (IN(pb + 4)) {
            FRESH();
            LAS unsigned char* wl_ = lds + wave * WLDS;
            constexpr int NU = 4 * 3 * 128 * 8, NU_A = NU / 6 * 5;
            const int NR = G * 4;
            if (wave < 4) {
                const int ia = bx * 4 + wave;
                for (int u = ia; u < 4096; u += NR) hg_pass_a(u, Z, UU, DEC, wl_, lane);
                const int per = (NU_A + NR - 1) / NR, u0 = ia * per, u1 = (u0 + per < NU_A) ? u0 + per : NU_A;
                for (int u = u0; u < u1; ++u) attn_unit(u, QB, QB + (size_t)MP * 512, QB + (size_t)2 * MP * 512, OPB, LSE, wl_, lane);
            } else {
                const int ib = bx * 4 + (wave - 4);
                for (int it = ib; it < MS * 24; it += NR) attn_sample_item(it, l, Z, args.in[2], args.in[3], OPB, LSE, (LAS v4u*)wl_, lane);
                for (int task = ib; task < 2048; task += NR) hgrn_sample_task(task, l, Z, OH, args.in[4], out + OFF_SS, (LAS float*)wl_, lane);
                const int per = (NU - NU_A + NR - 1) / NR, u0 = NU_A + ib * per, u1 = (u0 + per < NU) ? u0 + per : NU;
                for (int u = u0; u < u1; ++u) attn_unit(u, QB, QB + (size_t)MP * 512, QB + (size_t)2 * MP * 512, OPB, LSE, wl_, lane);
            }
        }
        SEAM(pb + 4);
        if (IN(pb + 5)) { FRESH(); hg_pass_b(UU, DEC, SPREV, out + OFF_SP + (size_t)l * 16 * 16384, bx * (NWAVES * 64) + tid, G * NWAVES * 64); }
        SEAM(pb + 5);
        if (IN(pb + 6)) {
            FRESH();
            for (int cg = bx; cg < 1024; cg += G) hg_pass_c(cg, Z, SPREV, args.in[14] + l * 128, OB, lds, tid);
            r3_phase(OPB, LSE, OH, Z, args.in[12] + l * 512, args.in[14] + l * 128, OB, gw, NGW, lane);
        }
        SEAM(pb + 6);
        if (IN(pb + 7)) {
            { FRESH(); small_gemm<D>(OB, wl + W_OUT, Y, lds, bx, G, tid); }
            pg8::Gemm g{OB, wl + W_OUT, MP, D, D}; pg8::StaticOrder S; S.init(MP, D, G, bx);
            EpiF32 E{Y, D};
            pg8::gemm_phase<EpiF32, pg8::StaticOrder, true, true>(lds, g, S, E);
        }
        SEAM(pb + 7);
        if (IN(pb + 8)) { FRESH(); row_phase<true>(HR, nullptr, Y, args.in[16] + l * D, 1.0f, HR, args.in[17] + l * D, XN, gw, NGW, lane); }
        SEAM(pb + 8);
        if (IN(pb + 9)) {
            pg8::Gemm g{XN, wl + W_G2, M, 2 * FF, D}; pg8::StaticOrder S; S.init(M, 2 * FF, G, bx);
            EpiSwiglu E{HID};
            pg8::gemm_phase<EpiSwiglu, pg8::StaticOrder, true, true>(lds, g, S, E);
        }
        SEAM(pb + 9);
        if (IN(pb + 10)) {
            { FRESH(); small_gemm<FF>(HID, wl + W_D2, Y, lds, bx, G, tid); }
            pg8::Gemm g{HID, wl + W_D2, MP, D, FF}; pg8::StaticOrder S; S.init(MP, D, G, bx);
            EpiF32 E{Y, D};
            pg8::gemm_phase<EpiF32, pg8::StaticOrder, true, true>(lds, g, S, E);
        }
        SEAM(pb + 10);
        if (IN(pb + 11)) {
            FRESH();
            if (l == 0) row_phase<true>(HR, nullptr, Y, args.in[21] + l * D, 0.5f, HR, args.in[5] + D, XN, gw, NGW, lane);
            else        row_phase<true>(HR, nullptr, Y, args.in[21] + l * D, 0.5f, out + OFF_Y, nullptr, nullptr, gw, NGW, lane);
        }
        SEAM(pb + 11);
    }
#undef IN
#undef SEAM
}

extern "C" void kernel_launch(void* const* d_in, const int* in_sizes, int n_in, void* d_out, int out_size, void* d_ws, size_t ws_size, hipStream_t stream) {
    static int grid = 0;
    if (grid == 0) {
        if (n_in != 22 || ws_size < WS_END) { fprintf(stderr, "kernel_launch: n_in %d ws %zu (need %zu)\n", n_in, ws_size, (size_t)WS_END); grid = -1; return; }
        int dev = 0, cus = 0, per_cu = 0;
        (void)hipGetDevice(&dev);
        (void)hipDeviceGetAttribute(&cus, hipDeviceAttributeMultiprocessorCount, dev);
        if (hipFuncSetAttribute((const void*)mk_fwd, hipFuncAttributeMaxDynamicSharedMemorySize, LDS_BYTES) != hipSuccess) { fprintf(stderr, "kernel_launch: hipFuncSetAttribute failed\n"); grid = -1; return; }
        if (hipOccupancyMaxActiveBlocksPerMultiprocessor(&per_cu, (const void*)mk_fwd, NWAVES * 64, LDS_BYTES) != hipSuccess || per_cu < 1) { fprintf(stderr, "kernel_launch: occupancy query says %d\n", per_cu); per_cu = 1; }
        (void)hipGetLastError();
        grid = cus * (per_cu > 1 ? 1 : per_cu);
        fprintf(stderr, "kernel_launch: grid %d (cus %d per_cu %d)\n", grid, cus, per_cu);
    }
    if (grid < 0) return;
    if (hipMemsetAsync((char*)d_ws + WS_BAR, 0, 16384, stream) != hipSuccess) { fprintf(stderr, "kernel_launch: memset failed\n"); return; }
    Args a{};
    for (int i = 0; i < 22; ++i) a.in[i] = (const float*)d_in[i];
    a.out = (float*)d_out; a.ws = (unsigned char*)d_ws;
#if MK_MULTI
    for (int p = 0; p < N_PHASES; ++p) {
        a.ph_lo = p; a.ph_hi = p + 1;
        void* kargs[] = {&a};
        hipError_t e = hipLaunchCooperativeKernel((const void*)mk_fwd, dim3(grid), dim3(NWAVES * 64), kargs, LDS_BYTES, stream);
        if (e != hipSuccess) { fprintf(stderr, "kernel_launch: launch %d failed: %s\n", p, hipGetErrorString(e)); break; }
    }
#else
    a.ph_lo = 0; a.ph_hi = N_PHASES;
    void* kargs[] = {&a};
    hipError_t e = hipLaunchCooperativeKernel((const void*)mk_fwd, dim3(grid), dim3(NWAVES * 64), kargs, LDS_BYTES, stream);
    if (e != hipSuccess) fprintf(stderr, "kernel_launch: cooperative launch failed: %s (grid %d)\n", hipGetErrorString(e), grid);
#endif
}
```
